# Optimizing an MI355X kernel written in HIP

```python
import math
import jax, jax.numpy as jnp
from jax import lax
import numpy as np

D_MODEL = 1024
BATCH = 8
SEQ = 4096
DEPTH = 2

M_HEADS = 4
M_V_WIDTH = 2 * D_MODEL
M_QK_WIDTH = D_MODEL
M_DV = M_V_WIDTH // M_HEADS
M_DK = M_QK_WIDTH // M_HEADS
M_CHUNK = 128
CONV_K = 4
A_HEADS = D_MODEL // 128
A_DH = 64
A_QK_WIDTH = A_HEADS * 2 * A_DH
A_V_WIDTH = A_HEADS * 2 * A_DH
Q_BLOCK = 128
REL_BUCKETS = 32
REL_MAX_DIST = 128
EPS = 1e-6

SPLITS = (M_QK_WIDTH, M_QK_WIDTH, M_V_WIDTH, M_V_WIDTH, M_V_WIDTH, M_HEADS, M_HEADS,
          A_QK_WIDTH, A_QK_WIDTH, A_V_WIDTH, A_V_WIDTH, D_MODEL, D_MODEL)
N_IN = 3 * M_QK_WIDTH - M_QK_WIDTH + 3 * M_V_WIDTH + 2 * M_HEADS + 2 * A_QK_WIDTH + 2 * A_V_WIDTH + 2 * D_MODEL

kernel_name = "hybrid_mlstm_diffattn_gated_block"


def rmsnorm(x, g):
    xf = x.astype(jnp.float32)
    y = xf * lax.rsqrt(jnp.mean(xf * xf, axis=-1, keepdims=True) + EPS)
    return (y * g.astype(jnp.float32)).astype(x.dtype)


def head_rmsnorm(x, n_heads, g):
    B, S, W = x.shape
    xf = x.astype(jnp.float32).reshape(B, S, n_heads, W // n_heads)
    xf = xf * lax.rsqrt(jnp.mean(xf * xf, axis=-1, keepdims=True) + EPS)
    return (xf.reshape(B, S, W) * g.astype(jnp.float32)).astype(x.dtype)


def causal_dwconv(x, w, b):
    S = x.shape[1]
    xp = jnp.pad(x, ((0, 0), (CONV_K - 1, 0), (0, 0)))
    y = xp[:, CONV_K - 1:CONV_K - 1 + S] * w[CONV_K - 1] + b
    for j in range(CONV_K - 1):
        y = y + xp[:, j:j + S] * w[j]
    return y


def t5_bucket(n):
    max_exact = REL_BUCKETS // 2
    nf = jnp.maximum(n, 1).astype(jnp.float32)
    large = max_exact + (jnp.log(nf / max_exact) / math.log(REL_MAX_DIST / max_exact)
                         * (REL_BUCKETS - max_exact)).astype(jnp.int32)
    large = jnp.minimum(large, REL_BUCKETS - 1)
    return jnp.where(n < max_exact, n, large)


def mlstm_chunkwise(q, k, v, i_pre, f_pre):
    in_dtype = v.dtype
    B, S, H, dk = q.shape
    dv = v.shape[-1]
    nc = S // M_CHUNK
    L = M_CHUNK
    f32 = jnp.float32

    def chunks4(t):
        return t.astype(f32).reshape(B, nc, L, H, t.shape[-1]).transpose(1, 0, 3, 2, 4)

    def chunks3(t):
        return t.astype(f32).reshape(B, nc, L, H).transpose(1, 0, 3, 2)

    qc = chunks4(q)
    kc = chunks4(k) * (dk ** -0.5)
    vc = chunks4(v)
    ic = chunks3(i_pre)
    lfc = jax.nn.log_sigmoid(chunks3(f_pre))
    causal = jnp.tril(jnp.ones((L, L), dtype=bool))

    def step(carry, xs):
        C, n, m = carry
        qx, kx, vx, ix, lfx = xs
        b = jnp.cumsum(lfx, axis=-1)
        D = b[..., :, None] - b[..., None, :] + ix[..., None, :]
        D = jnp.where(causal, D, -jnp.inf)
        inter = b + m[..., None]
        m_t = jnp.maximum(inter, jnp.max(D, axis=-1))
        w_inter = jnp.exp(inter - m_t)
        s = jnp.einsum('bhtd,bhsd->bhts', qx, kx) * jnp.exp(D - m_t[..., None])
        num = (w_inter[..., None] * jnp.einsum('bhvd,bhtd->bhtv', C, qx)
               + jnp.einsum('bhts,bhsv->bhtv', s, vx))
        den = w_inter * jnp.einsum('bhd,bhtd->bht', n, qx) + jnp.sum(s, axis=-1)
        h = num / jnp.maximum(jnp.abs(den), jnp.exp(-m_t))[..., None]
        bL = b[..., -1]
        g = bL[..., None] - b + ix
        m_new = jnp.maximum(bL + m, jnp.max(g, axis=-1))
        decay = jnp.exp(bL + m - m_new)
        wk = jnp.exp(g - m_new[..., None])
        C_new = decay[..., None, None] * C + jnp.einsum('bhsv,bhsd->bhvd', vx * wk[..., None], kx)
        n_new = decay[..., None] * n + jnp.einsum('bhs,bhsd->bhd', wk, kx)
        return (C_new, n_new, m_new), h

    init = (jnp.zeros((B, H, dv, dk), f32), jnp.zeros((B, H, dk), f32), jnp.zeros((B, H), f32))
    _, hs = lax.scan(step, init, (qc, kc, vc, ic, lfc))
    return hs.transpose(1, 0, 3, 2, 4).reshape(B, S, H, dv).astype(in_dtype)


def diff_attention(q, k, v, lam, rel_bias):
    in_dtype = v.dtype
    f32 = jnp.float32
    S = q.shape[1]
    qh = q.astype(f32).transpose(0, 2, 3, 1, 4) * (A_DH ** -0.5)
    kh = k.astype(f32).transpose(0, 2, 3, 1, 4)
    vh = v.astype(f32).transpose(0, 2, 1, 3)
    table = rel_bias.astype(f32)
    outs = []
    for blk in range(S // Q_BLOCK):
        q0 = blk * Q_BLOCK
        end = q0 + Q_BLOCK
        rel = jnp.arange(q0, end)[:, None] - jnp.arange(end)[None, :]
        bias = table[t5_bucket(jnp.maximum(rel, 0))]
        bias = jnp.where((rel >= 0)[..., None], bias, -jnp.inf).transpose(2, 0, 1)
        logits = jnp.einsum('bhmqd,bhmkd->bhmqk', qh[:, :, :, q0:end], kh[:, :, :, :end])
        p = jax.nn.softmax(logits + bias[None, :, None], axis=-1)
        a = p[:, :, 0] - lam * p[:, :, 1]
        outs.append(jnp.einsum('bhqk,bhkd->bhqd', a, vh[:, :, :end]))
    o = jnp.concatenate(outs, axis=2)
    return o.transpose(0, 2, 1, 3).astype(in_dtype)


def setup_inputs(seed: int = 0) -> dict:
    key = jax.random.key(seed)
    ks = jax.random.split(key, 24)
    nrm = jax.random.normal
    f32 = jnp.float32
    x = nrm(ks[0], (BATCH, SEQ, D_MODEL), f32)
    c = nrm(ks[1], (BATCH, D_MODEL), f32)
    norm_g = 1.0 + 0.05 * nrm(ks[2], (DEPTH, D_MODEL), f32)
    w_ada = 0.5 * D_MODEL ** -0.5 * nrm(ks[3], (DEPTH, D_MODEL, 3 * D_MODEL), f32)
    b_ada = 0.02 * nrm(ks[4], (DEPTH, 3 * D_MODEL), f32)
    w_in = D_MODEL ** -0.5 * nrm(ks[5], (DEPTH, D_MODEL, N_IN), f32)
    b_i = 0.1 * nrm(ks[6], (DEPTH, M_HEADS), f32)
    b_f = jnp.linspace(3.0, 6.0, M_HEADS, dtype=f32)[None] + 0.1 * nrm(ks[7], (DEPTH, M_HEADS), f32)
    b_if = jnp.concatenate([b_i, b_f], axis=-1)
    conv_w = CONV_K ** -0.5 * nrm(ks[8], (DEPTH, CONV_K, 2 * M_QK_WIDTH), f32)
    conv_b = 0.02 * nrm(ks[9], (DEPTH, 2 * M_QK_WIDTH), f32)
    mnorm_g = 1.0 + 0.05 * nrm(ks[10], (DEPTH, M_V_WIDTH), f32)
    w_proj_m = M_V_WIDTH ** -0.5 * nrm(ks[11], (DEPTH, M_V_WIDTH, D_MODEL), f32)
    lam_q1 = 0.1 * nrm(ks[12], (DEPTH, A_DH), f32)
    lam_k1 = 0.1 * nrm(ks[13], (DEPTH, A_DH), f32)
    lam_q2 = 0.1 * nrm(ks[14], (DEPTH, A_DH), f32)
    lam_k2 = 0.1 * nrm(ks[15], (DEPTH, A_DH), f32)
    anorm_g = 1.0 + 0.05 * nrm(ks[16], (DEPTH, A_V_WIDTH), f32)
    w_proj_a = A_V_WIDTH ** -0.5 * nrm(ks[17], (DEPTH, A_V_WIDTH, D_MODEL), f32)
    w_out = D_MODEL ** -0.5 * nrm(ks[18], (DEPTH, D_MODEL, D_MODEL), f32)
    rel_bias = 0.5 * nrm(ks[19], (REL_BUCKETS, A_HEADS), f32)
    final_g = 1.0 + 0.05 * nrm(ks[20], (D_MODEL,), f32)
    return {"x": x, "c": c, "norm_g": norm_g, "w_ada": w_ada, "b_ada": b_ada, "w_in": w_in,
            "b_if": b_if, "conv_w": conv_w, "conv_b": conv_b, "mnorm_g": mnorm_g, "w_proj_m": w_proj_m,
            "lam_q1": lam_q1, "lam_k1": lam_k1, "lam_q2": lam_q2, "lam_k2": lam_k2, "anorm_g": anorm_g,
            "w_proj_a": w_proj_a, "w_out": w_out, "rel_bias": rel_bias, "final_g": final_g}


def reference(x, c, norm_g, w_ada, b_ada, w_in, b_if, conv_w, conv_b, mnorm_g, w_proj_m,
              lam_q1, lam_k1, lam_q2, lam_k2, anorm_g, w_proj_a, w_out, rel_bias, final_g):
    B, S, _ = x.shape
    split_idx = np.cumsum(np.array(SPLITS))[:-1].tolist()
    c_act = jax.nn.silu(c)
    for l in range(DEPTH):
        mod = c_act @ w_ada[l] + b_ada[l]
        shift, scale, gate = jnp.split(mod, 3, axis=-1)
        h = rmsnorm(x, norm_g[l]) * (1.0 + scale[:, None]) + shift[:, None]

        proj = h @ w_in[l]
        (qm, km, vm, om, zm, im, fm, qa, ka, va, za, gm, ga) = jnp.split(proj, split_idx, axis=-1)

        qk = jax.nn.silu(causal_dwconv(jnp.concatenate([qm, km], axis=-1), conv_w[l], conv_b[l]))
        qm, km = jnp.split(qk, 2, axis=-1)
        im = im + b_if[l, :M_HEADS]
        fm = fm + b_if[l, M_HEADS:]
        hm = mlstm_chunkwise(qm.reshape(B, S, M_HEADS, M_DK), km.reshape(B, S, M_HEADS, M_DK),
                             vm.reshape(B, S, M_HEADS, M_DV), im, fm)
        hm = jax.nn.sigmoid(om) * hm.reshape(B, S, M_V_WIDTH)
        hm = head_rmsnorm(hm, M_HEADS, mnorm_g[l]) * jax.nn.silu(zm)
        ym = hm @ w_proj_m[l]

        lam_init = 0.8 - 0.6 * math.exp(-0.3 * l)
        lam = (jnp.exp(jnp.sum(lam_q1[l].astype(jnp.float32) * lam_k1[l].astype(jnp.float32)))
               - jnp.exp(jnp.sum(lam_q2[l].astype(jnp.float32) * lam_k2[l].astype(jnp.float32)))
               + lam_init)
        ha = diff_attention(qa.reshape(B, S, A_HEADS, 2, A_DH), ka.reshape(B, S, A_HEADS, 2, A_DH),
                            va.reshape(B, S, A_HEADS, 2 * A_DH), lam, rel_bias)
        ha = head_rmsnorm(ha.reshape(B, S, A_V_WIDTH), A_HEADS, anorm_g[l]) * (1.0 - lam_init)
        ha = ha * jax.nn.silu(za)
        ya = ha @ w_proj_a[l]

        y = jax.nn.sigmoid(gm) * ym + jax.nn.sigmoid(ga) * ya
        x = x + gate[:, None] * (y @ w_out[l])
    return rmsnorm(x, final_g)
```

```cpp
#include <hip/hip_runtime.h>
#include <hip/hip_cooperative_groups.h>
#include <cstdio>
#include <cstdint>
namespace cg = cooperative_groups;

typedef unsigned short bf16_t;
typedef short bf16x8 __attribute__((ext_vector_type(8)));
typedef short s16x4 __attribute__((ext_vector_type(4)));
typedef float f32x16 __attribute__((ext_vector_type(16)));
typedef float f32x4 __attribute__((ext_vector_type(4)));
typedef unsigned u32x4 __attribute__((ext_vector_type(4)));
typedef unsigned u32x2 __attribute__((ext_vector_type(2)));
#define DI __device__ __forceinline__
#define MFMA32(a, b, c) __builtin_amdgcn_mfma_f32_32x32x16_bf16((a), (b), (c), 0, 0, 0)

constexpr int DM = 1024, SEQ = 4096, NBATCH = 8, TOK = 8192  , NIN = 14344, NPK = 14336, NATW = 11264;
constexpr int C_QM = 0, C_KM = 1024, C_OM = 2048, C_ZM = 4096, C_QA = 6144, C_KA = 7168, C_ZA = 8192, C_GM = 9216, C_GA = 10240;
constexpr float EPS = 1e-6f, LOG2E = 1.4426950408889634f;

constexpr size_t al256(size_t x) { return (x + 255) & ~(size_t)255; }
constexpr size_t OFF_CNT = 0;
constexpr size_t OFF_MOD = 4096;
constexpr size_t OFF_WG = OFF_MOD + al256(2 * 8 * 3072 * 4);
constexpr size_t OFF_GI = OFF_WG + al256(2 * 1024 * 8 * 4);
constexpr size_t OFF_GF = OFF_GI + 131072;
constexpr size_t OFF_GA = OFF_GF + 131072;
constexpr size_t OFF_GMM = OFF_GA + 131072;
constexpr size_t OFF_GWI = OFF_GMM + 131072;
constexpr size_t OFF_GEM = OFF_GWI + 131072;
constexpr size_t OFF_GWK = OFF_GEM + 131072;
constexpr size_t OFF_GDEC = OFF_GWK + 131072;
constexpr size_t OFF_NLOC = OFF_GDEC + 1024;
constexpr size_t OFF_WTIN = OFF_NLOC + 262144;
constexpr size_t OFF_WTPM = OFF_WTIN + (size_t)2 * NPK * 1024 * 2;
constexpr size_t OFF_WTPA = OFF_WTPM + (size_t)2 * 1024 * 2048 * 2;
constexpr size_t OFF_WTOUT = OFF_WTPA + (size_t)2 * 1024 * 1024 * 2;
constexpr size_t OFF_H = OFF_WTOUT + (size_t)2 * 1024 * 1024 * 2;
constexpr size_t OFF_NAT = OFF_H + (size_t)TOK * 1024 * 2;
constexpr size_t OFF_VMT = OFF_NAT + (size_t)TOK * NATW * 2;
constexpr size_t OFF_VAT = OFF_VMT + (size_t)2 * 2048 * 4096 * 2;
constexpr size_t OFF_Q = OFF_VAT + (size_t)2 * 1024 * 4096 * 2;
constexpr size_t OFF_KN = OFF_Q + (size_t)TOK * 1024 * 2;
constexpr size_t OFF_KT = OFF_KN + (size_t)TOK * 1024 * 2;
constexpr size_t OFF_CST = OFF_KT + (size_t)TOK * 1024 * 2;
constexpr size_t OFF_HM = OFF_CST + (size_t)8 * 32 * 512 * 256 * 2;
constexpr size_t WS_END = OFF_HM + (size_t)TOK * 2048 * 2;

struct Params {
  const float *x, *c, *norm_g, *w_ada, *b_ada, *w_in, *b_if, *conv_w, *conv_b, *mnorm_g, *w_proj_m, *lam_q1, *lam_k1, *lam_q2, *lam_k2, *anorm_g, *w_proj_a, *w_out, *rel_bias, *final_g;
  float* out;
  unsigned char* ws;
};

DI int get_tid() { int t = (int)__builtin_amdgcn_workitem_id_x(); asm volatile("" : "+v"(t)); return t; }
DI unsigned short f2bf(float x) { unsigned u = __float_as_uint(x); u += 0x7fffu + ((u >> 16) & 1u); return (unsigned short)(u >> 16); }
DI unsigned pack2(float a, float b) { return (unsigned)f2bf(a) | ((unsigned)f2bf(b) << 16); }
DI float bflo(unsigned v) { return __uint_as_float(v << 16); }
DI float bfhi(unsigned v) { return __uint_as_float(v & 0xffff0000u); }
DI float sigmoidf_(float x) { return 1.0f / (1.0f + __expf(-x)); }
DI float siluf_(float x) { return x / (1.0f + __expf(-x)); }
DI float wave_sum(float v) {
#pragma unroll
  for (int o = 32; o > 0; o >>= 1) v += __shfl_xor(v, o);
  return v;
}

constexpr int LDT = 72;
constexpr int CORE_SM = 2 * 128 * LDT;
template <bool A_LDS>
DI void gemm_core(const bf16_t* __restrict__ A, int lda, const bf16_t* __restrict__ B, int ldb, int K, f32x16 (&acc)[2][2], bf16_t* sm,
                  const bf16_t* aL, int ldaL) {
  const int tid = get_tid(), lane = tid & 63, w = tid >> 6, wm = w >> 1, wn = w & 1, r = lane & 31, h = lane >> 5;
  bf16_t* As = sm;
  bf16_t* Bs = sm + 128 * LDT;
  const int lr = tid >> 3, lc = (tid & 7) * 8;
  u32x4 ra[4], rb[4];
  const int nk = K >> 6;
#pragma unroll
  for (int p = 0; p < 4; ++p) {
    if (!A_LDS) ra[p] = *(const u32x4*)(A + (size_t)(lr + 32 * p) * lda + lc);
    rb[p] = *(const u32x4*)(B + (size_t)(lr + 32 * p) * ldb + lc);
  }
#pragma unroll 1
  for (int kt = 0; kt < nk; ++kt) {
    __syncthreads();
#pragma unroll
    for (int p = 0; p < 4; ++p) {
      if (!A_LDS) *(u32x4*)(As + (lr + 32 * p) * LDT + lc) = ra[p];
      *(u32x4*)(Bs + (lr + 32 * p) * LDT + lc) = rb[p];
    }
    __syncthreads();
    if (kt + 1 < nk) {
      const int ko = (kt + 1) * 64 + lc;
#pragma unroll
      for (int p = 0; p < 4; ++p) {
        if (!A_LDS) ra[p] = *(const u32x4*)(A + (size_t)(lr + 32 * p) * lda + ko);
        rb[p] = *(const u32x4*)(B + (size_t)(lr + 32 * p) * ldb + ko);
      }
    }
#pragma unroll
    for (int kk = 0; kk < 4; ++kk) {
      bf16x8 af[2], bfr[2];
#pragma unroll
      for (int i = 0; i < 2; ++i) {
        if (A_LDS) af[i] = *(const bf16x8*)(aL + (64 * wm + 32 * i + r) * ldaL + kt * 64 + kk * 16 + 8 * h);
        else af[i] = *(const bf16x8*)(As + (64 * wm + 32 * i + r) * LDT + kk * 16 + 8 * h);
      }
#pragma unroll
      for (int j = 0; j < 2; ++j) bfr[j] = *(const bf16x8*)(Bs + (64 * wn + 32 * j + r) * LDT + kk * 16 + 8 * h);
#pragma unroll
      for (int i = 0; i < 2; ++i)
#pragma unroll
        for (int j = 0; j < 2; ++j) acc[i][j] = MFMA32(bfr[j], af[i], acc[i][j]);
    }
  }
}

DI void acc_zero(f32x16 (&acc)[2][2]) {
#pragma unroll
  for (int i = 0; i < 2; ++i)
#pragma unroll
    for (int j = 0; j < 2; ++j)
#pragma unroll
      for (int e = 0; e < 16; ++e) acc[i][j][e] = 0.f;
}

template <class F>
DI void for_quads(f32x16 (&acc)[2][2], F f) {
  const int lane = get_tid() & 63, w = get_tid() >> 6, wm = w >> 1, wn = w & 1, r = lane & 31, h = lane >> 5;
#pragma unroll
  for (int i = 0; i < 2; ++i)
#pragma unroll
    for (int j = 0; j < 2; ++j)
#pragma unroll
      for (int g = 0; g < 4; ++g) {
        float v0 = acc[i][j][4 * g], v1 = acc[i][j][4 * g + 1], v2 = acc[i][j][4 * g + 2], v3 = acc[i][j][4 * g + 3];
        f(64 * wm + 32 * i + r, 64 * wn + 32 * j + 8 * g + 4 * h, i, v0, v1, v2, v3);
        acc[i][j][4 * g] = v0; acc[i][j][4 * g + 1] = v1; acc[i][j][4 * g + 2] = v2; acc[i][j][4 * g + 3] = v3;
      }
}

DI void transpose_tile(const float* __restrict__ src, int ldsrc, int srccol0, bf16_t* __restrict__ dst, int lddst, int dstrow0, int k0, float* smf) {
  const int tid = get_tid();
  __syncthreads();
#pragma unroll 4
  for (int i = 0; i < 16; ++i) { const int k = i * 4 + (tid >> 6), n = tid & 63; smf[k * 65 + n] = src[(size_t)(k0 + k) * ldsrc + srccol0 + n]; }
  __syncthreads();
#pragma unroll 4
  for (int i = 0; i < 16; ++i) { const int n = i * 4 + (tid >> 6), k = tid & 63; dst[(size_t)(dstrow0 + n) * lddst + k0 + k] = f2bf(smf[k * 65 + n]); }
}

DI void phase0(const Params& p, float* smf) {
  const int tid = get_tid();
  unsigned char* ws = p.ws;
  if (blockIdx.x == 0 && tid < 64) ((int*)(ws + OFF_CNT))[tid * 16] = 0;
  const int NT_IN = 16 * 224, NT_PM = 32 * 16, NT_PA = 16 * 16, NT_OUT = 16 * 16, PER_L = NT_IN + NT_PM + NT_PA + NT_OUT;
  const int N_TR = 2 * PER_L, N_MOD = 192, N_WG = 2;
  for (int it = blockIdx.x; it < N_TR + N_MOD + N_WG; it += gridDim.x) {
    if (it < N_TR) {
      const int l = it / PER_L;
      int q = it % PER_L;
      if (q < NT_IN) {
        const int nt = q / 16, kt = q % 16, n0 = nt * 64, sc = n0 < 8192 ? n0 : n0 + 8;
        transpose_tile(p.w_in + (size_t)l * 1024 * NIN, NIN, sc, (bf16_t*)(ws + OFF_WTIN) + (size_t)l * NPK * 1024, 1024, n0, kt * 64, smf);
      } else if ((q -= NT_IN) < NT_PM) {
        const int nt = q / 32, kt = q % 32;
        transpose_tile(p.w_proj_m + (size_t)l * 2048 * 1024, 1024, nt * 64, (bf16_t*)(ws + OFF_WTPM) + (size_t)l * 1024 * 2048, 2048, nt * 64, kt * 64, smf);
      } else if ((q -= NT_PM) < NT_PA) {
        const int nt = q / 16, kt = q % 16;
        transpose_tile(p.w_proj_a + (size_t)l * 1024 * 1024, 1024, nt * 64, (bf16_t*)(ws + OFF_WTPA) + (size_t)l * 1024 * 1024, 1024, nt * 64, kt * 64, smf);
      } else {
        q -= NT_PA;
        const int nt = q / 16, kt = q % 16;
        transpose_tile(p.w_out + (size_t)l * 1024 * 1024, 1024, nt * 64, (bf16_t*)(ws + OFF_WTOUT) + (size_t)l * 1024 * 1024, 1024, nt * 64, kt * 64, smf);
      }
    } else if (it < N_TR + N_MOD) {
      const int q = it - N_TR, l = q / 96, ch = q % 96;
      float* cact = smf;
      float* part = smf + 8192;
      __syncthreads();
      for (int i = tid; i < 8192; i += 256) cact[i] = siluf_(p.c[i]);
      __syncthreads();
      const int col = ch * 32 + (tid & 31), kg = tid >> 5;
      float a[8];
#pragma unroll
      for (int b = 0; b < 8; ++b) a[b] = 0.f;
      const float* wp = p.w_ada + (size_t)l * 1024 * 3072 + col;
      for (int k = kg * 128; k < kg * 128 + 128; ++k) {
        const float wv = wp[(size_t)k * 3072];
#pragma unroll
        for (int b = 0; b < 8; ++b) a[b] += cact[b * 1024 + k] * wv;
      }
#pragma unroll
      for (int b = 0; b < 8; ++b) part[(kg * 8 + b) * 32 + (tid & 31)] = a[b];
      __syncthreads();
      {
        const int b = tid >> 5, cc = tid & 31;
        float s = 0.f;
#pragma unroll
        for (int g = 0; g < 8; ++g) s += part[(g * 8 + b) * 32 + cc];
        const int colo = ch * 32 + cc;
        ((float*)(ws + OFF_MOD))[(l * 8 + b) * 3072 + colo] = s + p.b_ada[l * 3072 + colo];
      }
    } else {
      const int l = it - N_TR - N_MOD;
      float* wg = (float*)(ws + OFF_WG) + l * 8192;
      for (int i = tid; i < 8192; i += 256) wg[i] = p.w_in[(size_t)l * 1024 * NIN + (size_t)(i >> 3) * NIN + 8192 + (i & 7)];
    }
  }
}

DI void norm_rows(const Params& p, int l, int grp, int item_begin, int item_stride) {
  const int tid = get_tid(), lane = tid & 63, w = tid >> 6;
  unsigned char* ws = p.ws;
  const float* xin = (l == 0) ? p.x : p.out;
  const float* mod = (const float*)(ws + OFF_MOD);
  const float* wg = (const float*)(ws + OFF_WG) + l * 8192;
  bf16_t* H = (bf16_t*)(ws + OFF_H);
  float* GI = (float*)(ws + OFF_GI);
  float* GF = (float*)(ws + OFF_GF);
  for (int it = item_begin; it < TOK / 4; it += item_stride) {
    const int tl = it * 4 + w, bl = tl >> 12, t = tl & 4095, bg = grp * 2 + bl;
    const float* xr = xin + ((size_t)grp * TOK + tl) * DM;
    f32x4 xv[4];
    float ss = 0.f;
#pragma unroll
    for (int i = 0; i < 4; ++i) { xv[i] = *(const f32x4*)(xr + 256 * i + 4 * lane); ss += xv[i][0] * xv[i][0] + xv[i][1] * xv[i][1] + xv[i][2] * xv[i][2] + xv[i][3] * xv[i][3]; }
    ss = wave_sum(ss);
    const float rstd = rsqrtf(ss * (1.0f / DM) + EPS);
    float ga[8];
#pragma unroll
    for (int j = 0; j < 8; ++j) ga[j] = 0.f;
    const float* mrow = mod + (l * 8 + bg) * 3072;
#pragma unroll
    for (int i = 0; i < 4; ++i) {
      const int col = 256 * i + 4 * lane;
      const f32x4 g = *(const f32x4*)(p.norm_g + l * DM + col), sh = *(const f32x4*)(mrow + col), sc = *(const f32x4*)(mrow + 1024 + col);
      float hv[4];
#pragma unroll
      for (int e = 0; e < 4; ++e) hv[e] = xv[i][e] * rstd * g[e] * (1.0f + sc[e]) + sh[e];
      u32x2 o; o[0] = pack2(hv[0], hv[1]); o[1] = pack2(hv[2], hv[3]);
      *(u32x2*)(H + (size_t)tl * DM + col) = o;
#pragma unroll
      for (int e = 0; e < 4; ++e) {
        const f32x4 w0 = *(const f32x4*)(wg + (col + e) * 8), w1 = *(const f32x4*)(wg + (col + e) * 8 + 4);
#pragma unroll
        for (int j = 0; j < 4; ++j) { ga[j] += hv[e] * w0[j]; ga[4 + j] += hv[e] * w1[j]; }
      }
    }
#pragma unroll
    for (int j = 0; j < 8; ++j) ga[j] = wave_sum(ga[j]);
    if (lane < 8) {
      float v = ga[0];
#pragma unroll
      for (int j = 1; j < 8; ++j) v = (lane == j) ? ga[j] : v;
      v += p.b_if[l * 8 + lane];
      const int hh = lane & 3;
      float* dst = (lane < 4) ? GI : GF;
      dst[(bl * 4 + hh) * 4096 + t] = v;
    }
  }
}

DI void gate_scan(const Params& p, int bh) {
  const int lane = get_tid() & 63;
  unsigned char* ws = p.ws;
  const float* GI = (const float*)(ws + OFF_GI) + bh * 4096;
  const float* GF = (const float*)(ws + OFF_GF) + bh * 4096;
  float* GA = (float*)(ws + OFF_GA) + bh * 4096;
  float* GMM = (float*)(ws + OFF_GMM) + bh * 4096;
  float* GWI = (float*)(ws + OFF_GWI) + bh * 4096;
  float* GEM = (float*)(ws + OFF_GEM) + bh * 4096;
  float* GWK = (float*)(ws + OFF_GWK) + bh * 4096;
  float* GDEC = (float*)(ws + OFF_GDEC) + bh * 32;
  float mprev = 0.f;
  for (int c = 0; c < 32; ++c) {
    const int t = c * 128 + 2 * lane;
    const float f0 = GF[t], f1 = GF[t + 1], i0 = GI[t], i1 = GI[t + 1];
    const float lf0 = fminf(f0, 0.f) - log1pf(__expf(-fabsf(f0))), lf1 = fminf(f1, 0.f) - log1pf(__expf(-fabsf(f1)));
    const float ps = lf0 + lf1;
    float inc = ps;
#pragma unroll
    for (int o = 1; o < 64; o <<= 1) { const float v = __shfl_up(inc, o); if (lane >= o) inc += v; }
    const float b0 = inc - ps + lf0, b1 = inc;
    const float a0 = i0 - b0, a1 = i1 - b1;
    float mxi = fmaxf(a0, a1);
#pragma unroll
    for (int o = 1; o < 64; o <<= 1) { const float v = __shfl_up(mxi, o); if (lane >= o) mxi = fmaxf(mxi, v); }
    float exm = __shfl_up(mxi, 1);
    if (lane == 0) exm = -INFINITY;
    const float cm0 = fmaxf(exm, a0), cm1 = fmaxf(cm0, a1);
    const float mm0 = fmaxf(mprev, cm0), mm1 = fmaxf(mprev, cm1);
    const float mml = __shfl(mm1, 63), bL = __shfl(b1, 63);
    GA[t] = a0; GA[t + 1] = a1;
    GMM[t] = mm0; GMM[t + 1] = mm1;
    GWI[t] = __expf(mprev - mm0); GWI[t + 1] = __expf(mprev - mm1);
    GEM[t] = __expf(-(b0 + mm0)); GEM[t + 1] = __expf(-(b1 + mm1));
    GWK[t] = __expf(a0 - mml); GWK[t + 1] = __expf(a1 - mml);
    if (lane == 0) GDEC[c] = __expf(mprev - mml);
    mprev = bL + mml;
  }
}

DI void inproj_tile(const Params& p, int l, int mt, int nt, bf16_t* sm) {
  unsigned char* ws = p.ws;
  const bf16_t* H = (const bf16_t*)(ws + OFF_H) + (size_t)mt * 128 * DM;
  const bf16_t* W = (const bf16_t*)(ws + OFF_WTIN) + ((size_t)l * NPK + (size_t)nt * 128) * 1024;
  const int n0 = nt * 128;
  bool tr = false; int dcol = 0; bf16_t* tb = nullptr;
  if (n0 < 2048) dcol = n0;
  else if (n0 < 4096) { tr = true; tb = (bf16_t*)(ws + OFF_VMT) + ((size_t)((mt >> 5) * 2048 + (n0 - 2048))) * 4096 + (mt & 31) * 128; }
  else if (n0 < 10240) dcol = n0 - 2048;
  else if (n0 < 11264) { tr = true; tb = (bf16_t*)(ws + OFF_VAT) + ((size_t)((mt >> 5) * 1024 + (n0 - 10240))) * 4096 + (mt & 31) * 128; }
  else dcol = n0 - 3072;
  f32x16 acc[2][2];
  acc_zero(acc);
  if (!tr) {
    gemm_core<false>(H, DM, W, 1024, 1024, acc, sm, nullptr, 0);
    bf16_t* dst = (bf16_t*)(ws + OFF_NAT) + (size_t)mt * 128 * NATW + dcol;
    for_quads(acc, [&](int ar, int br, int ii, float v0, float v1, float v2, float v3) {
      u32x2 o; o[0] = pack2(v0, v1); o[1] = pack2(v2, v3);
      *(u32x2*)(dst + (size_t)ar * NATW + br) = o;
    });
  } else {
    gemm_core<false>(W, 1024, H, DM, 1024, acc, sm, nullptr, 0);
    for_quads(acc, [&](int ar, int br, int ii, float v0, float v1, float v2, float v3) {
      u32x2 o; o[0] = pack2(v0, v1); o[1] = pack2(v2, v3);
      *(u32x2*)(tb + (size_t)ar * 4096 + br) = o;
    });
  }
}

DI void conv_item(const Params& p, int l, int idx) {
  const int tid = get_tid();
  unsigned char* ws = p.ws;
  const int which = idx & 1, c = (idx >> 1) & 31, bh = idx >> 6, bl = bh >> 2, h = bh & 3;
  const int ch = which * 1024 + h * 256 + tid;
  const float w0 = p.conv_w[(l * 4 + 0) * 2048 + ch], w1 = p.conv_w[(l * 4 + 1) * 2048 + ch], w2 = p.conv_w[(l * 4 + 2) * 2048 + ch], w3 = p.conv_w[(l * 4 + 3) * 2048 + ch];
  const float bias = p.conv_b[l * 2048 + ch];
  const bf16_t* src = (const bf16_t*)(ws + OFF_NAT) + (size_t)bl * 4096 * NATW + (which ? C_KM : C_QM) + h * 256 + tid;
  const int t0 = c * 128;
  float x0 = 0.f, x1 = 0.f, x2 = 0.f;
  if (t0 > 0) { x0 = bflo(src[(size_t)(t0 - 3) * NATW]); x1 = bflo(src[(size_t)(t0 - 2) * NATW]); x2 = bflo(src[(size_t)(t0 - 1) * NATW]); }
  if (which == 0) {
    bf16_t* Q = (bf16_t*)(ws + OFF_Q) + (size_t)bl * 4096 * 1024 + h * 256 + tid;
#pragma unroll 8
    for (int t = t0; t < t0 + 128; ++t) {
      const float x3 = bflo(src[(size_t)t * NATW]);
      const float y = w3 * x3 + bias + w0 * x0 + w1 * x1 + w2 * x2;
      Q[(size_t)t * 1024] = f2bf(siluf_(y));
      x0 = x1; x1 = x2; x2 = x3;
    }
  } else {
    bf16_t* KN = (bf16_t*)(ws + OFF_KN) + (size_t)bl * 4096 * 1024 + h * 256 + tid;
    bf16_t* KT = (bf16_t*)(ws + OFF_KT) + (size_t)(bh * 256 + tid) * 4096;
    const float* GWK = (const float*)(ws + OFF_GWK) + bh * 4096;
    float nacc = 0.f;
    for (int tb = t0; tb < t0 + 128; tb += 8) {
      float ks[8];
#pragma unroll
      for (int e = 0; e < 8; ++e) {
        const int t = tb + e;
        const float x3 = bflo(src[(size_t)t * NATW]);
        const float y = w3 * x3 + bias + w0 * x0 + w1 * x1 + w2 * x2;
        const float kv = siluf_(y) * 0.0625f;
        KN[(size_t)t * 1024] = f2bf(kv);
        ks[e] = kv * GWK[t];
        nacc += ks[e];
        x0 = x1; x1 = x2; x2 = x3;
      }
      u32x4 o; o[0] = pack2(ks[0], ks[1]); o[1] = pack2(ks[2], ks[3]); o[2] = pack2(ks[4], ks[5]); o[3] = pack2(ks[6], ks[7]);
      *(u32x4*)(KT + tb) = o;
    }
    ((float*)(ws + OFF_NLOC))[(bh * 32 + c) * 256 + tid] = nacc;
  }
}

DI void state_chain(const Params& p, int idx, bf16_t* sm) {
  unsigned char* ws = p.ws;
  const int bh = idx >> 3, i2 = (idx >> 2) & 1, j4 = idx & 3, bl = bh >> 2, h = bh & 3;
  const bf16_t* VT = (const bf16_t*)(ws + OFF_VMT) + (size_t)(bl * 2048 + h * 512 + j4 * 128) * 4096;
  const bf16_t* KT = (const bf16_t*)(ws + OFF_KT) + (size_t)(bh * 256 + i2 * 128) * 4096;
  const float* GDEC = (const float*)(ws + OFF_GDEC) + bh * 32;
  f32x16 acc[2][2];
  acc_zero(acc);
#pragma unroll 1
  for (int c = 0; c < 32; ++c) {
    bf16_t* dst = (bf16_t*)(ws + OFF_CST) + ((size_t)(bh * 32 + c) * 512 + j4 * 128) * 256 + i2 * 128;
    for_quads(acc, [&](int ar, int br, int ii, float v0, float v1, float v2, float v3) {
      u32x2 o; o[0] = pack2(v0, v1); o[1] = pack2(v2, v3);
      *(u32x2*)(dst + (size_t)ar * 256 + br) = o;
    });
    if (c == 31) break;
    const float dec = GDEC[c];
#pragma unroll
    for (int i = 0; i < 2; ++i)
#pragma unroll
      for (int j = 0; j < 2; ++j) acc[i][j] *= dec;
    gemm_core<false>(VT + c * 128, 4096, KT + c * 128, 4096, 128, acc, sm, nullptr, 0);
  }
}

constexpr int LDP = 136;
DI void mlstm_out_item(const Params& p, int l, int idx, bf16_t* sm) {
  const int tid = get_tid(), lane = tid & 63, h5 = lane >> 5;
  unsigned char* ws = p.ws;
  const int bh = idx >> 5, c = idx & 31, bl = bh >> 2, h = bh & 3;
  const size_t tok0 = (size_t)bl * 4096 + c * 128;
  bf16_t* Ps = sm + CORE_SM;
  float* vec = (float*)(sm + CORE_SM + 128 * LDP);
  float *sa = vec, *smm = vec + 128, *swi = vec + 256, *sden = vec + 384, *ssq = vec + 512, *sn = vec + 640;
  const bf16_t* Q = (const bf16_t*)(ws + OFF_Q) + tok0 * 1024 + h * 256;
  const bf16_t* KN = (const bf16_t*)(ws + OFF_KN) + tok0 * 1024 + h * 256;
  const float* GDEC = (const float*)(ws + OFF_GDEC) + bh * 32;
  const float* GEM = (const float*)(ws + OFF_GEM) + bh * 4096 + c * 128;
  __syncthreads();
  if (tid < 128) {
    sa[tid] = ((const float*)(ws + OFF_GA))[bh * 4096 + c * 128 + tid];
    smm[tid] = ((const float*)(ws + OFF_GMM))[bh * 4096 + c * 128 + tid];
    swi[tid] = ((const float*)(ws + OFF_GWI))[bh * 4096 + c * 128 + tid];
    sden[tid] = 0.f;
    ssq[tid] = 0.f;
  }
  {
    float n = 0.f;
    const float* NL = (const float*)(ws + OFF_NLOC) + (size_t)bh * 32 * 256 + tid;
    for (int cc = 0; cc < c; ++cc) n = n * GDEC[cc] + NL[cc * 256];
    sn[tid] = n;
  }
  __syncthreads();
  {
    const int t = tid >> 1, half = tid & 1;
    const bf16_t* qr = Q + (size_t)t * 1024 + half * 128;
    float d = 0.f;
#pragma unroll 4
    for (int k = 0; k < 128; k += 8) {
      const u32x4 v = *(const u32x4*)(qr + k);
      const float* nn = sn + half * 128 + k;
      d += bflo(v[0]) * nn[0] + bfhi(v[0]) * nn[1] + bflo(v[1]) * nn[2] + bfhi(v[1]) * nn[3] + bflo(v[2]) * nn[4] + bfhi(v[2]) * nn[5] + bflo(v[3]) * nn[6] + bfhi(v[3]) * nn[7];
    }
    atomicAdd(&sden[t], swi[t] * d);
  }
  f32x16 acc[2][2];
  acc_zero(acc);
  gemm_core<false>(Q, 1024, KN, 1024, 256, acc, sm, nullptr, 0);
  {
    float psum[2] = {0.f, 0.f};
    const int w = tid >> 6, wm = w >> 1, r = lane & 31;
    for_quads(acc, [&](int ar, int br, int ii, float v0, float v1, float v2, float v3) {
      const float mt = smm[ar];
      const f32x4 av = *(const f32x4*)(sa + br);
      const float p0 = (br + 0 <= ar) ? v0 * __expf(av[0] - mt) : 0.f;
      const float p1 = (br + 1 <= ar) ? v1 * __expf(av[1] - mt) : 0.f;
      const float p2 = (br + 2 <= ar) ? v2 * __expf(av[2] - mt) : 0.f;
      const float p3 = (br + 3 <= ar) ? v3 * __expf(av[3] - mt) : 0.f;
      psum[ii] += (p0 + p1) + (p2 + p3);
      u32x2 o; o[0] = pack2(p0, p1); o[1] = pack2(p2, p3);
      *(u32x2*)(Ps + ar * LDP + br) = o;
    });
#pragma unroll
    for (int i = 0; i < 2; ++i) {
      float s = psum[i];
      s += __shfl_xor(s, 32);
      if (h5 == 0) atomicAdd(&sden[64 * wm + 32 * i + r], s);
    }
  }
  __syncthreads();
  const bf16_t* OMp = (const bf16_t*)(ws + OFF_NAT) + tok0 * NATW + C_OM + h * 512;
  const bf16_t* ZMp = (const bf16_t*)(ws + OFF_NAT) + tok0 * NATW + C_ZM + h * 512;
  bf16_t* HMp = (bf16_t*)(ws + OFF_HM) + tok0 * 2048 + h * 512;
  float sq[2] = {0.f, 0.f};
#pragma unroll 1
  for (int j4 = 0; j4 < 4; ++j4) {
    acc_zero(acc);
    if (c > 0) {
      gemm_core<false>(Q, 1024, (const bf16_t*)(ws + OFF_CST) + ((size_t)(bh * 32 + c) * 512 + j4 * 128) * 256, 256, 256, acc, sm, nullptr, 0);
      for_quads(acc, [&](int ar, int br, int ii, float& v0, float& v1, float& v2, float& v3) { const float s = swi[ar]; v0 *= s; v1 *= s; v2 *= s; v3 *= s; });
    }
    gemm_core<true>(nullptr, 0, (const bf16_t*)(ws + OFF_VMT) + (size_t)(bl * 2048 + h * 512 + j4 * 128) * 4096 + c * 128, 4096, 128, acc, sm, Ps, LDP);
    for_quads(acc, [&](int ar, int br, int ii, float v0, float v1, float v2, float v3) {
      const float den = 1.0f / fmaxf(fabsf(sden[ar]), GEM[ar]);
      const u32x2 ov = *(const u32x2*)(OMp + (size_t)ar * NATW + j4 * 128 + br);
      const float h0 = v0 * den * sigmoidf_(bflo(ov[0])), h1 = v1 * den * sigmoidf_(bfhi(ov[0])), h2 = v2 * den * sigmoidf_(bflo(ov[1])), h3 = v3 * den * sigmoidf_(bfhi(ov[1]));
      sq[ii] += (h0 * h0 + h1 * h1) + (h2 * h2 + h3 * h3);
      u32x2 o; o[0] = pack2(h0, h1); o[1] = pack2(h2, h3);
      *(u32x2*)(HMp + (size_t)ar * 2048 + j4 * 128 + br) = o;
    });
  }
  {
    const int w = tid >> 6, wm = w >> 1, r = lane & 31;
#pragma unroll
    for (int i = 0; i < 2; ++i) {
      float s = sq[i];
      s += __shfl_xor(s, 32);
      if (h5 == 0) atomicAdd(&ssq[64 * wm + 32 * i + r], s);
    }
  }
  __syncthreads();
#pragma unroll 1
  for (int j4 = 0; j4 < 4; ++j4) {
    for_quads(acc, [&](int ar, int br, int ii, float, float, float, float) {
      const float rs = rsqrtf(ssq[ar] * (1.0f / 512.0f) + EPS);
      const int col = j4 * 128 + br;
      const u32x2 hv = *(const u32x2*)(HMp + (size_t)ar * 2048 + col);
      const u32x2 zv = *(const u32x2*)(ZMp + (size_t)ar * NATW + col);
      const f32x4 g = *(const f32x4*)(p.mnorm_g + l * 2048 + h * 512 + col);
      u32x2 o;
      o[0] = pack2(bflo(hv[0]) * rs * g[0] * siluf_(bflo(zv[0])), bfhi(hv[0]) * rs * g[1] * siluf_(bfhi(zv[0])));
      o[1] = pack2(bflo(hv[1]) * rs * g[2] * siluf_(bflo(zv[1])), bfhi(hv[1]) * rs * g[3] * siluf_(bfhi(zv[1])));
      *(u32x2*)(HMp + (size_t)ar * 2048 + col) = o;
    });
  }
}

#define MFMA16(a, b, c) __builtin_amdgcn_mfma_f32_16x16x32_bf16((a), (b), (c), 0, 0, 0)
DI void attn_item(const Params& p, int l, int bl, int hd, int qb, bf16_t* sm) {
  const int tid = get_tid(), lane = tid & 63, w = tid >> 6, r16 = lane & 15, q4 = lane >> 4;
  unsigned char* ws = p.ws;
  bf16_t* Ks = sm;
  bf16_t* Vs = sm + 2 * 64 * LDT;
  float* tb = (float*)(sm + 2 * 64 * LDT + 128 * LDT);
  const bf16_t* NAT = (const bf16_t*)(ws + OFF_NAT) + (size_t)bl * 4096 * NATW;
  const bf16_t* VT = (const bf16_t*)(ws + OFF_VAT) + (size_t)(bl * 1024 + hd * 128) * 4096;
  const int Q0 = qb * 64, t0 = Q0 + 16 * w, t = t0 + r16;
  float lam;
  {
    float s1 = 0.f, s2 = 0.f;
    for (int i = 0; i < 64; ++i) { s1 += p.lam_q1[l * 64 + i] * p.lam_k1[l * 64 + i]; s2 += p.lam_q2[l * 64 + i] * p.lam_k2[l * 64 + i]; }
    lam = __expf(s1) - __expf(s2) + (l == 0 ? 0.2f : 0.35550906f);
  }
  const float oml = (l == 0) ? 0.8f : 0.64449094f;
  __syncthreads();
  if (tid < 129) {
    int bucket;
    if (tid < 16) bucket = tid;
    else { const float v = logf((float)tid / 16.0f) / 2.0794415416798357f * 16.0f; bucket = 16 + (int)v; if (bucket > 31) bucket = 31; }
    tb[tid] = p.rel_bias[bucket * 8 + hd] * LOG2E;
  }
  bf16x8 qf[2][2];
#pragma unroll
  for (int m = 0; m < 2; ++m)
#pragma unroll
    for (int kk = 0; kk < 2; ++kk) qf[m][kk] = *(const bf16x8*)(NAT + (size_t)t * NATW + C_QA + hd * 128 + m * 64 + kk * 32 + 8 * q4);
  f32x4 O[2][8];
#pragma unroll
  for (int m = 0; m < 2; ++m)
#pragma unroll
    for (int jd = 0; jd < 8; ++jd)
#pragma unroll
      for (int e = 0; e < 4; ++e) O[m][jd][e] = 0.f;
  float Mx[2] = {-INFINITY, -INFINITY}, Ls[2] = {0.f, 0.f};
  const int ntile = qb + 1;
  const float c1 = 0.125f * LOG2E;
#pragma unroll 1
  for (int kt = 0; kt < ntile; ++kt) {
    const int s0 = kt * 64;
    __syncthreads();
#pragma unroll
    for (int pp = 0; pp < 4; ++pp) {
      const int id = tid + 256 * pp;
      { const int m = id >> 9, row = (id >> 3) & 63, ch = id & 7;
        *(u32x4*)(Ks + (m * 64 + row) * LDT + ch * 8) = *(const u32x4*)(NAT + (size_t)(s0 + row) * NATW + C_KA + hd * 128 + m * 64 + ch * 8); }
      { const int row = id >> 3, ch = id & 7;
        *(u32x4*)(Vs + row * LDT + ch * 8) = *(const u32x4*)(VT + (size_t)row * 4096 + s0 + ch * 8); }
    }
    __syncthreads();
    if (s0 <= t0 + 15) {
      const bool diag = (s0 + 63 > t0);
      const bool nearb = (s0 + 63 + 128 > t0);
      const float tb128 = tb[128];
      f32x4 sacc[2][4];
#pragma unroll
      for (int m = 0; m < 2; ++m)
#pragma unroll
        for (int st = 0; st < 4; ++st) {
#pragma unroll
          for (int e = 0; e < 4; ++e) sacc[m][st][e] = 0.f;
#pragma unroll
          for (int kk = 0; kk < 2; ++kk) {
            const bf16x8 a = *(const bf16x8*)(Ks + (m * 64 + 16 * st + r16) * LDT + kk * 32 + 8 * q4);
            sacc[m][st] = MFMA16(a, qf[m][kk], sacc[m][st]);
          }
        }
#pragma unroll
      for (int m = 0; m < 2; ++m) {
        float mx = -INFINITY;
#pragma unroll
        for (int st = 0; st < 4; ++st)
#pragma unroll
          for (int e = 0; e < 4; ++e) {
            const int s = s0 + 16 * st + 4 * q4 + e;
            const int rel = t - s;
            float bv = tb128;
            if (nearb) { int ri = rel < 0 ? 0 : rel; ri = ri > 128 ? 128 : ri; bv = tb[ri]; }
            float xv = sacc[m][st][e] * c1 + bv;
            if (diag && rel < 0) xv = -INFINITY;
            sacc[m][st][e] = xv;
            mx = fmaxf(mx, xv);
          }
        mx = fmaxf(mx, __shfl_xor(mx, 16));
        mx = fmaxf(mx, __shfl_xor(mx, 32));
        const float Mn = fmaxf(Mx[m], mx);
        const float alpha = __builtin_amdgcn_exp2f(Mx[m] - Mn);
        Mx[m] = Mn;
        float ps = 0.f;
#pragma unroll
        for (int st = 0; st < 4; ++st)
#pragma unroll
          for (int e = 0; e < 4; ++e) { const float pv = __builtin_amdgcn_exp2f(sacc[m][st][e] - Mn); sacc[m][st][e] = pv; ps += pv; }
        Ls[m] = Ls[m] * alpha + ps;
#pragma unroll
        for (int jd = 0; jd < 8; ++jd) O[m][jd] *= alpha;
      }
#pragma unroll
      for (int u = 0; u < 2; ++u) {
        u32x4 pk0, pk1;
        pk0[0] = pack2(sacc[0][2 * u][0], sacc[0][2 * u][1]); pk0[1] = pack2(sacc[0][2 * u][2], sacc[0][2 * u][3]);
        pk0[2] = pack2(sacc[0][2 * u + 1][0], sacc[0][2 * u + 1][1]); pk0[3] = pack2(sacc[0][2 * u + 1][2], sacc[0][2 * u + 1][3]);
        pk1[0] = pack2(sacc[1][2 * u][0], sacc[1][2 * u][1]); pk1[1] = pack2(sacc[1][2 * u][2], sacc[1][2 * u][3]);
        pk1[2] = pack2(sacc[1][2 * u + 1][0], sacc[1][2 * u + 1][1]); pk1[3] = pack2(sacc[1][2 * u + 1][2], sacc[1][2 * u + 1][3]);
        const bf16x8 pf0 = __builtin_bit_cast(bf16x8, pk0), pf1 = __builtin_bit_cast(bf16x8, pk1);
#pragma unroll
        for (int jd = 0; jd < 8; ++jd) {
          const bf16_t* vp = Vs + (16 * jd + r16) * LDT + 32 * u + 4 * q4;
          const s16x4 lo = *(const s16x4*)vp, hi = *(const s16x4*)(vp + 16);
          const bf16x8 vf = __builtin_shufflevector(lo, hi, 0, 1, 2, 3, 4, 5, 6, 7);
          O[0][jd] = MFMA16(vf, pf0, O[0][jd]);
          O[1][jd] = MFMA16(vf, pf1, O[1][jd]);
        }
      }
    }
  }
  float L1 = Ls[0], L2 = Ls[1];
  L1 += __shfl_xor(L1, 16); L1 += __shfl_xor(L1, 32);
  L2 += __shfl_xor(L2, 16); L2 += __shfl_xor(L2, 32);
  const float i1 = 1.0f / L1, i2 = lam / L2;
  float ss = 0.f;
#pragma unroll
  for (int jd = 0; jd < 8; ++jd)
#pragma unroll
    for (int e = 0; e < 4; ++e) { const float o = O[0][jd][e] * i1 - O[1][jd][e] * i2; O[0][jd][e] = o; ss += o * o; }
  ss += __shfl_xor(ss, 16); ss += __shfl_xor(ss, 32);
  const float rs = rsqrtf(ss * (1.0f / 128.0f) + EPS) * oml;
  const bf16_t* ZA = NAT + (size_t)t * NATW + C_ZA + hd * 128;
  bf16_t* HA = (bf16_t*)(ws + OFF_H) + ((size_t)bl * 4096 + t) * 1024 + hd * 128;
  const float* ag = p.anorm_g + l * 1024 + hd * 128;
#pragma unroll
  for (int jd = 0; jd < 8; ++jd) {
    const int dv = 16 * jd + 4 * q4;
    const u32x2 zv = *(const u32x2*)(ZA + dv);
    const f32x4 gg = *(const f32x4*)(ag + dv);
    u32x2 o;
    o[0] = pack2(O[0][jd][0] * rs * gg[0] * siluf_(bflo(zv[0])), O[0][jd][1] * rs * gg[1] * siluf_(bfhi(zv[0])));
    o[1] = pack2(O[0][jd][2] * rs * gg[2] * siluf_(bflo(zv[1])), O[0][jd][3] * rs * gg[3] * siluf_(bfhi(zv[1])));
    *(u32x2*)(HA + dv) = o;
  }
}

DI void proj_tile(const Params& p, int l, int mt, int nt, bf16_t* sm) {
  unsigned char* ws = p.ws;
  f32x16 acc[2][2];
  acc_zero(acc);
  gemm_core<false>((const bf16_t*)(ws + OFF_HM) + (size_t)mt * 128 * 2048, 2048, (const bf16_t*)(ws + OFF_WTPM) + ((size_t)l * 1024 + nt * 128) * 2048, 2048, 2048, acc, sm, nullptr, 0);
  const bf16_t* G = (const bf16_t*)(ws + OFF_NAT) + (size_t)mt * 128 * NATW + nt * 128;
  for_quads(acc, [&](int ar, int br, int ii, float& v0, float& v1, float& v2, float& v3) {
    const u32x2 gm = *(const u32x2*)(G + (size_t)ar * NATW + C_GM + br), ga = *(const u32x2*)(G + (size_t)ar * NATW + C_GA + br);
    v0 *= (1.0f + __expf(-bflo(ga[0]))) / (1.0f + __expf(-bflo(gm[0])));
    v1 *= (1.0f + __expf(-bfhi(ga[0]))) / (1.0f + __expf(-bfhi(gm[0])));
    v2 *= (1.0f + __expf(-bflo(ga[1]))) / (1.0f + __expf(-bflo(gm[1])));
    v3 *= (1.0f + __expf(-bfhi(ga[1]))) / (1.0f + __expf(-bfhi(gm[1])));
  });
  gemm_core<false>((const bf16_t*)(ws + OFF_H) + (size_t)mt * 128 * 1024, 1024, (const bf16_t*)(ws + OFF_WTPA) + ((size_t)l * 1024 + nt * 128) * 1024, 1024, 1024, acc, sm, nullptr, 0);
  bf16_t* Y = (bf16_t*)(ws + OFF_Q) + (size_t)mt * 128 * 1024 + nt * 128;
  for_quads(acc, [&](int ar, int br, int ii, float v0, float v1, float v2, float v3) {
    const u32x2 ga = *(const u32x2*)(G + (size_t)ar * NATW + C_GA + br);
    u32x2 o;
    o[0] = pack2(v0 * sigmoidf_(bflo(ga[0])), v1 * sigmoidf_(bfhi(ga[0])));
    o[1] = pack2(v2 * sigmoidf_(bflo(ga[1])), v3 * sigmoidf_(bfhi(ga[1])));
    *(u32x2*)(Y + (size_t)ar * 1024 + br) = o;
  });
}

DI void out_tile(const Params& p, int l, int grp, int mt, int nt, bf16_t* sm) {
  unsigned char* ws = p.ws;
  f32x16 acc[2][2];
  acc_zero(acc);
  gemm_core<false>((const bf16_t*)(ws + OFF_Q) + (size_t)mt * 128 * 1024, 1024, (const bf16_t*)(ws + OFF_WTOUT) + ((size_t)l * 1024 + nt * 128) * 1024, 1024, 1024, acc, sm, nullptr, 0);
  const float* xin = ((l == 0) ? p.x : p.out) + ((size_t)grp * TOK + mt * 128) * DM + nt * 128;
  float* xo = p.out + ((size_t)grp * TOK + mt * 128) * DM + nt * 128;
  const float* gate = (const float*)(ws + OFF_MOD) + (l * 8 + grp * 2 + (mt >> 5)) * 3072 + 2048 + nt * 128;
  for_quads(acc, [&](int ar, int br, int ii, float v0, float v1, float v2, float v3) {
    const f32x4 xv = *(const f32x4*)(xin + (size_t)ar * DM + br);
    const f32x4 gv = *(const f32x4*)(gate + br);
    f32x4 o; o[0] = xv[0] + gv[0] * v0; o[1] = xv[1] + gv[1] * v1; o[2] = xv[2] + gv[2] * v2; o[3] = xv[3] + gv[3] * v3;
    *(f32x4*)(xo + (size_t)ar * DM + br) = o;
  });
}

DI void final_norm(const Params& p) {
  const int tid = get_tid(), lane = tid & 63, w = tid >> 6;
  for (int it = blockIdx.x; it < NBATCH * SEQ / 4; it += gridDim.x) {
    float* xr = p.out + ((size_t)it * 4 + w) * DM;
    f32x4 xv[4];
    float ss = 0.f;
#pragma unroll
    for (int i = 0; i < 4; ++i) { xv[i] = *(const f32x4*)(xr + 256 * i + 4 * lane); ss += xv[i][0] * xv[i][0] + xv[i][1] * xv[i][1] + xv[i][2] * xv[i][2] + xv[i][3] * xv[i][3]; }
    ss = wave_sum(ss);
    const float rstd = rsqrtf(ss * (1.0f / DM) + EPS);
#pragma unroll
    for (int i = 0; i < 4; ++i) {
      const f32x4 g = *(const f32x4*)(p.final_g + 256 * i + 4 * lane);
      f32x4 o; o[0] = xv[i][0] * rstd * g[0]; o[1] = xv[i][1] * rstd * g[1]; o[2] = xv[i][2] * rstd * g[2]; o[3] = xv[i][3] * rstd * g[3];
      *(f32x4*)(xr + 256 * i + 4 * lane) = o;
    }
  }
}

constexpr int SMEM_BYTES = (CORE_SM + 128 * LDP) * 2 + 1024 * 4;

__global__ void __launch_bounds__(256, 2) fwd_megakernel(Params p) {
  cg::grid_group grid = cg::this_grid();
  extern __shared__ __attribute__((aligned(16))) unsigned char smem_raw[];
  bf16_t* sm = (bf16_t*)smem_raw;
  __shared__ int s_item;
  const int tid = get_tid();
  int* cnt = (int*)(p.ws + OFF_CNT);

  phase0(p, (float*)smem_raw);
  grid.sync();
  norm_rows(p, 0, 0, blockIdx.x, gridDim.x);
  grid.sync();

  for (int rd = 0; rd < 8; ++rd) {
    const int l = rd >> 2, grp = rd & 3;
    if (blockIdx.x < 8 && tid < 64) gate_scan(p, blockIdx.x);
    for (int it = blockIdx.x; it < 64 * 112; it += gridDim.x) inproj_tile(p, l, it & 63, it >> 6, sm);
    grid.sync();
    for (int it = blockIdx.x; it < 512; it += gridDim.x) conv_item(p, l, it);
    grid.sync();
    for (;;) {
      __syncthreads();
      if (tid == 0) s_item = atomicAdd(&cnt[rd * 16], 1);
      __syncthreads();
      const int it = s_item;
      if (it >= 64 + 1024) break;
#ifndef NO_CHAIN
      if (it < 64) state_chain(p, it, sm);
#endif
#ifndef NO_ATTN
      if (it >= 64) { const int k = it - 64; attn_item(p, l, (k >> 3) & 1, k & 7, 63 - (k >> 4), sm); }
#endif
    }
    grid.sync();
#ifndef NO_MOUT
    for (int it = blockIdx.x; it < 256; it += gridDim.x) mlstm_out_item(p, l, it, sm);
#endif
    grid.sync();
    for (int it = blockIdx.x; it < 512; it += gridDim.x) proj_tile(p, l, it & 63, it >> 6, sm);
    grid.sync();
    for (int it = blockIdx.x; it < 512; it += gridDim.x) out_tile(p, l, grp, it & 63, it >> 6, sm);
    if (rd < 7) norm_rows(p, (rd + 1) >> 2, (rd + 1) & 3, blockIdx.x, gridDim.x);
    grid.sync();
  }
  final_norm(p);
}

extern "C" void kernel_launch(void* const* d_in, const int* in_sizes, int n_in, void* d_out, int out_size, void* d_ws, size_t ws_size, hipStream_t stream) {
  static int grid_blocks = 0;
  if (!grid_blocks) {
    int dev = 0, cus = 0, per_cu = 0;
    hipGetDevice(&dev);
    hipDeviceGetAttribute(&cus, hipDeviceAttributeMultiprocessorCount, dev);
    hipFuncSetAttribute((const void*)fwd_megakernel, hipFuncAttributeMaxDynamicSharedMemorySize, SMEM_BYTES);
    hipOccupancyMaxActiveBlocksPerMultiprocessor(&per_cu, (const void*)fwd_megakernel, 256, SMEM_BYTES);
    if (per_cu < 1) per_cu = 1;
    if (per_cu > 2) per_cu = 2;
    grid_blocks = cus * per_cu;
    if (ws_size < WS_END) fprintf(stderr, "kernel_launch: workspace too small: %zu < %zu\n", ws_size, (size_t)WS_END);
  }
  Params p{};
  const float** pp = (const float**)&p;
  for (int i = 0; i < 20; ++i) pp[i] = (const float*)d_in[i];
  p.out = (float*)d_out;
  p.ws = (unsigned char*)d_ws;
  void* args[] = {&p};
  hipError_t e = hipLaunchCooperativeKernel((const void*)fwd_megakernel, dim3(grid_blocks), dim3(256), args, SMEM_BYTES, stream);
  if (e != hipSuccess) fprintf(stderr, "cooperative launch failed: %s (grid %d)\n", hipGetErrorString(e), grid_blocks);
}
```

```cpp
#include <hip/hip_runtime.h>
#define SGB 1
#include <hip/hip_cooperative_groups.h>
#include <cstdio>
#include <cstdint>
namespace cg = cooperative_groups;

typedef unsigned short bf16_t;
typedef short bf16x8 __attribute__((ext_vector_type(8)));
typedef short s16x4 __attribute__((ext_vector_type(4)));
typedef float f32x16 __attribute__((ext_vector_type(16)));
typedef float f32x4 __attribute__((ext_vector_type(4)));
typedef unsigned u32x4 __attribute__((ext_vector_type(4)));
typedef unsigned u32x2 __attribute__((ext_vector_type(2)));
#define DI __device__ __forceinline__
#define MFMA32(a, b, c) __builtin_amdgcn_mfma_f32_32x32x16_bf16((a), (b), (c), 0, 0, 0)

constexpr int DM = 1024, SEQ = 4096, NBATCH = 8, TOK = 8192  , NIN = 14344, NPK = 14336, NATW = 11264;
constexpr int C_QM = 0, C_KM = 1024, C_OM = 2048, C_ZM = 4096, C_QA = 6144, C_KA = 7168, C_ZA = 8192, C_GM = 9216, C_GA = 10240;
constexpr float EPS = 1e-6f, LOG2E = 1.4426950408889634f;

constexpr size_t al256(size_t x) { return (x + 255) & ~(size_t)255; }
constexpr size_t OFF_CNT = 0;
constexpr size_t OFF_BAR = 4096;
constexpr size_t OFF_MOD = 20480;
constexpr size_t OFF_WG = OFF_MOD + al256(2 * 8 * 3072 * 4);
constexpr size_t OFF_GI = OFF_WG + al256(2 * 1024 * 8 * 4);
constexpr size_t OFF_GF = OFF_GI + 131072;
constexpr size_t OFF_GA = OFF_GF + 131072;
constexpr size_t OFF_GMM = OFF_GA + 131072;
constexpr size_t OFF_GWI = OFF_GMM + 131072;
constexpr size_t OFF_GEM = OFF_GWI + 131072;
constexpr size_t OFF_GWK = OFF_GEM + 131072;
constexpr size_t OFF_GDEC = OFF_GWK + 131072;
constexpr size_t OFF_NLOC = OFF_GDEC + 1024;
constexpr size_t OFF_WTIN = OFF_NLOC + 262144;
constexpr size_t OFF_WTPM = OFF_WTIN + (size_t)2 * NPK * 1024 * 2;
constexpr size_t OFF_WTPA = OFF_WTPM + (size_t)2 * 1024 * 2048 * 2;
constexpr size_t OFF_WTOUT = OFF_WTPA + (size_t)2 * 1024 * 1024 * 2;
constexpr size_t OFF_H = OFF_WTOUT + (size_t)2 * 1024 * 1024 * 2;
constexpr size_t OFF_NAT = OFF_H + (size_t)TOK * 1024 * 2;
constexpr size_t OFF_VMT = OFF_NAT + (size_t)TOK * NATW * 2;
constexpr size_t OFF_VAT = OFF_VMT + (size_t)2 * 2048 * 4096 * 2;
constexpr size_t OFF_Q = OFF_VAT + (size_t)2 * 1024 * 4096 * 2;
constexpr size_t OFF_KN = OFF_Q + (size_t)TOK * 1024 * 2;
constexpr size_t OFF_KT = OFF_KN + (size_t)TOK * 1024 * 2;
constexpr size_t OFF_CST = OFF_KT + (size_t)TOK * 1024 * 2;
constexpr size_t OFF_HM = OFF_CST + (size_t)8 * 32 * 512 * 256 * 2;
constexpr size_t OFF_HA = OFF_HM + (size_t)TOK * 2048 * 2;
constexpr size_t OFF_RS = OFF_HA + (size_t)TOK * 1024 * 2;
constexpr size_t WS_END = OFF_RS + (size_t)TOK * 4 * 4;

struct Params {
  const float *x, *c, *norm_g, *w_ada, *b_ada, *w_in, *b_if, *conv_w, *conv_b, *mnorm_g, *w_proj_m, *lam_q1, *lam_k1, *lam_q2, *lam_k2, *anorm_g, *w_proj_a, *w_out, *rel_bias, *final_g;
  float* out;
  unsigned char* ws;
};

DI int get_tid() { int t = (int)__builtin_amdgcn_workitem_id_x(); asm volatile("" : "+v"(t)); return t; }
DI unsigned short f2bf(float x) { return __builtin_bit_cast(unsigned short, (__bf16)x); }
typedef __bf16 hbf2 __attribute__((ext_vector_type(2)));
typedef float f32x2 __attribute__((ext_vector_type(2)));
DI unsigned pack2(float a, float b) { f32x2 v = {a, b}; hbf2 r = __builtin_convertvector(v, hbf2); return __builtin_bit_cast(unsigned, r); }
DI float bflo(unsigned v) { return __uint_as_float(v << 16); }
DI float bfhi(unsigned v) { return __uint_as_float(v & 0xffff0000u); }
DI float sigmoidf_(float x) { return 1.0f / (1.0f + __expf(-x)); }
DI float siluf_(float x) { return x / (1.0f + __expf(-x)); }
DI float wave_sum(float v) {
#pragma unroll
  for (int o = 32; o > 0; o >>= 1) v += __shfl_xor(v, o);
  return v;
}

constexpr int LDT = 72;
constexpr int CORE_SM = 2 * 128 * LDT;
struct NoHook { DI void operator()(int) const {} };
template <bool A_LDS, bool DB, class Hook = NoHook>
DI void gemm_core(const bf16_t* __restrict__ A, int lda, const bf16_t* __restrict__ B, int ldb, int K, f32x16 (&acc)[2][2], bf16_t* sm,
                  const bf16_t* aL, int ldaL, Hook hook = Hook()) {
  const int tid = get_tid(), lane = tid & 63, w = tid >> 6, wm = w >> 1, wn = w & 1, r = lane & 31, h = lane >> 5;
  const int lr = tid >> 3, lc = (tid & 7) * 8;
  u32x4 ra[4], rb[4];
  const int nk = K >> 6;
#pragma unroll
  for (int p = 0; p < 4; ++p) {
    if (!A_LDS) ra[p] = *(const u32x4*)(A + (size_t)(lr + 32 * p) * lda + lc);
    rb[p] = *(const u32x4*)(B + (size_t)(lr + 32 * p) * ldb + lc);
  }
  if (DB) {
    __syncthreads();
#pragma unroll
    for (int p = 0; p < 4; ++p) {
      if (!A_LDS) *(u32x4*)(sm + (lr + 32 * p) * LDT + lc) = ra[p];
      *(u32x4*)(sm + 128 * LDT + (lr + 32 * p) * LDT + lc) = rb[p];
    }
    if (nk > 1) {
#pragma unroll
      for (int p = 0; p < 4; ++p) {
        if (!A_LDS) ra[p] = *(const u32x4*)(A + (size_t)(lr + 32 * p) * lda + 64 + lc);
        rb[p] = *(const u32x4*)(B + (size_t)(lr + 32 * p) * ldb + 64 + lc);
      }
    }
    __syncthreads();
  }
#pragma unroll 1
  for (int kt = 0; kt < nk; ++kt) {
    hook(kt);
    bf16_t* As;
    if (DB) {
      As = sm + (kt & 1) * CORE_SM;
      bf16_t* Nx = sm + ((kt + 1) & 1) * CORE_SM;
      if (kt + 1 < nk) {
#pragma unroll
        for (int p = 0; p < 4; ++p) {
          if (!A_LDS) *(u32x4*)(Nx + (lr + 32 * p) * LDT + lc) = ra[p];
          *(u32x4*)(Nx + 128 * LDT + (lr + 32 * p) * LDT + lc) = rb[p];
        }
      }
      if (kt + 2 < nk) {
        const int ko = (kt + 2) * 64 + lc;
#pragma unroll
        for (int p = 0; p < 4; ++p) {
          if (!A_LDS) ra[p] = *(const u32x4*)(A + (size_t)(lr + 32 * p) * lda + ko);
          rb[p] = *(const u32x4*)(B + (size_t)(lr + 32 * p) * ldb + ko);
        }
      }
    } else {
      As = sm;
      __syncthreads();
#pragma unroll
      for (int p = 0; p < 4; ++p) {
        if (!A_LDS) *(u32x4*)(As + (lr + 32 * p) * LDT + lc) = ra[p];
        *(u32x4*)(As + 128 * LDT + (lr + 32 * p) * LDT + lc) = rb[p];
      }
      __syncthreads();
      if (kt + 1 < nk) {
        const int ko = (kt + 1) * 64 + lc;
#pragma unroll
        for (int p = 0; p < 4; ++p) {
          if (!A_LDS) ra[p] = *(const u32x4*)(A + (size_t)(lr + 32 * p) * lda + ko);
          rb[p] = *(const u32x4*)(B + (size_t)(lr + 32 * p) * ldb + ko);
        }
      }
    }
    const bf16_t* Bs = As + 128 * LDT;
    __builtin_amdgcn_s_setprio(2);
#pragma unroll
    for (int kk = 0; kk < 4; ++kk) {
      bf16x8 af[2], bfr[2];
#pragma unroll
      for (int i = 0; i < 2; ++i) {
        if (A_LDS) af[i] = *(const bf16x8*)(aL + (64 * wm + 32 * i + r) * ldaL + kt * 64 + kk * 16 + 8 * h);
        else af[i] = *(const bf16x8*)(As + (64 * wm + 32 * i + r) * LDT + kk * 16 + 8 * h);
      }
#pragma unroll
      for (int j = 0; j < 2; ++j) bfr[j] = *(const bf16x8*)(Bs + (64 * wn + 32 * j + r) * LDT + kk * 16 + 8 * h);
#pragma unroll
      for (int i = 0; i < 2; ++i)
#pragma unroll
        for (int j = 0; j < 2; ++j) acc[i][j] = MFMA32(bfr[j], af[i], acc[i][j]);
    }
#ifdef SGB
    __builtin_amdgcn_sched_group_barrier(0x100, 4, 0);
#pragma unroll
    for (int q = 0; q < 12; ++q) { __builtin_amdgcn_sched_group_barrier(0x008, 1, 0); __builtin_amdgcn_sched_group_barrier(0x100, 1, 0); }
    __builtin_amdgcn_sched_group_barrier(0x008, 4, 0);
#endif
    __builtin_amdgcn_s_setprio(0);
    if (DB) __syncthreads();
  }
}

DI void acc_zero(f32x16 (&acc)[2][2]) {
#pragma unroll
  for (int i = 0; i < 2; ++i)
#pragma unroll
    for (int j = 0; j < 2; ++j)
#pragma unroll
      for (int e = 0; e < 16; ++e) acc[i][j][e] = 0.f;
}

template <class F>
DI void for_quads(f32x16 (&acc)[2][2], F f) {
  const int lane = get_tid() & 63, w = get_tid() >> 6, wm = w >> 1, wn = w & 1, r = lane & 31, h = lane >> 5;
#pragma unroll
  for (int i = 0; i < 2; ++i)
#pragma unroll
    for (int j = 0; j < 2; ++j)
#pragma unroll
      for (int g = 0; g < 4; ++g) {
        float v0 = acc[i][j][4 * g], v1 = acc[i][j][4 * g + 1], v2 = acc[i][j][4 * g + 2], v3 = acc[i][j][4 * g + 3];
        f(64 * wm + 32 * i + r, 64 * wn + 32 * j + 8 * g + 4 * h, i, v0, v1, v2, v3);
        acc[i][j][4 * g] = v0; acc[i][j][4 * g + 1] = v1; acc[i][j][4 * g + 2] = v2; acc[i][j][4 * g + 3] = v3;
      }
}

DI void transpose_tile(const float* __restrict__ src, int ldsrc, int srccol0, bf16_t* __restrict__ dst, int lddst, int dstrow0, int k0, float* smf) {
  const int tid = get_tid();
  __syncthreads();
#pragma unroll 4
  for (int i = 0; i < 16; ++i) { const int k = i * 4 + (tid >> 6), n = tid & 63; smf[k * 65 + n] = src[(size_t)(k0 + k) * ldsrc + srccol0 + n]; }
  __syncthreads();
#pragma unroll 4
  for (int i = 0; i < 16; ++i) { const int n = i * 4 + (tid >> 6), k = tid & 63; dst[(size_t)(dstrow0 + n) * lddst + k0 + k] = f2bf(smf[k * 65 + n]); }
}

DI void phase0(const Params& p, float* smf) {
  const int tid = get_tid();
  unsigned char* ws = p.ws;
  const int NT_IN = 16 * 224, NT_PM = 32 * 16, NT_PA = 16 * 16, NT_OUT = 16 * 16, PER_L = NT_IN + NT_PM + NT_PA + NT_OUT;
  const int N_TR = 2 * PER_L, N_MOD = 192, N_WG = 2;
  for (int it = blockIdx.x; it < N_TR + N_MOD + N_WG; it += gridDim.x) {
    if (it < N_TR) {
      const int l = it / PER_L;
      int q = it % PER_L;
      if (q < NT_IN) {
        const int nt = q / 16, kt = q % 16, n0 = nt * 64, sc = n0 < 8192 ? n0 : n0 + 8;
        transpose_tile(p.w_in + (size_t)l * 1024 * NIN, NIN, sc, (bf16_t*)(ws + OFF_WTIN) + (size_t)l * NPK * 1024, 1024, n0, kt * 64, smf);
      } else if ((q -= NT_IN) < NT_PM) {
        const int nt = q / 32, kt = q % 32;
        transpose_tile(p.w_proj_m + (size_t)l * 2048 * 1024, 1024, nt * 64, (bf16_t*)(ws + OFF_WTPM) + (size_t)l * 1024 * 2048, 2048, nt * 64, kt * 64, smf);
      } else if ((q -= NT_PM) < NT_PA) {
        const int nt = q / 16, kt = q % 16;
        transpose_tile(p.w_proj_a + (size_t)l * 1024 * 1024, 1024, nt * 64, (bf16_t*)(ws + OFF_WTPA) + (size_t)l * 1024 * 1024, 1024, nt * 64, kt * 64, smf);
      } else {
        q -= NT_PA;
        const int nt = q / 16, kt = q % 16;
        transpose_tile(p.w_out + (size_t)l * 1024 * 1024, 1024, nt * 64, (bf16_t*)(ws + OFF_WTOUT) + (size_t)l * 1024 * 1024, 1024, nt * 64, kt * 64, smf);
      }
    } else if (it < N_TR + N_MOD) {
      const int q = it - N_TR, l = q / 96, ch = q % 96;
      float* cact = smf;
      float* part = smf + 8192;
      __syncthreads();
      for (int i = tid; i < 8192; i += 256) cact[i] = siluf_(p.c[i]);
      __syncthreads();
      const int col = ch * 32 + (tid & 31), kg = tid >> 5;
      float a[8];
#pragma unroll
      for (int b = 0; b < 8; ++b) a[b] = 0.f;
      const float* wp = p.w_ada + (size_t)l * 1024 * 3072 + col;
      for (int k = kg * 128; k < kg * 128 + 128; ++k) {
        const float wv = wp[(size_t)k * 3072];
#pragma unroll
        for (int b = 0; b < 8; ++b) a[b] += cact[b * 1024 + k] * wv;
      }
#pragma unroll
      for (int b = 0; b < 8; ++b) part[(kg * 8 + b) * 32 + (tid & 31)] = a[b];
      __syncthreads();
      {
        const int b = tid >> 5, cc = tid & 31;
        float s = 0.f;
#pragma unroll
        for (int g = 0; g < 8; ++g) s += part[(g * 8 + b) * 32 + cc];
        const int colo = ch * 32 + cc;
        ((float*)(ws + OFF_MOD))[(l * 8 + b) * 3072 + colo] = s + p.b_ada[l * 3072 + colo];
      }
    } else {
      const int l = it - N_TR - N_MOD;
      float* wg = (float*)(ws + OFF_WG) + l * 8192;
      for (int i = tid; i < 8192; i += 256) wg[i] = p.w_in[(size_t)l * 1024 * NIN + (size_t)(i >> 3) * NIN + 8192 + (i & 7)];
    }
  }
}

DI void norm_rows(const Params& p, int l, int grp, int item_begin, int item_stride) {
  const int tid = get_tid(), lane = tid & 63, w = tid >> 6;
  unsigned char* ws = p.ws;
  const float* xin = (l == 0) ? p.x : p.out;
  const float* mod = (const float*)(ws + OFF_MOD);
  const float* wg = (const float*)(ws + OFF_WG) + l * 8192;
  bf16_t* H = (bf16_t*)(ws + OFF_H);
  float* GI = (float*)(ws + OFF_GI);
  float* GF = (float*)(ws + OFF_GF);
  for (int it = item_begin; it < TOK / 4; it += item_stride) {
    const int tl = it * 4 + w, bl = tl >> 12, t = tl & 4095, bg = grp * 2 + bl;
    const float* xr = xin + ((size_t)grp * TOK + tl) * DM;
    f32x4 xv[4];
    float ss = 0.f;
#pragma unroll
    for (int i = 0; i < 4; ++i) { xv[i] = *(const f32x4*)(xr + 256 * i + 4 * lane); ss += xv[i][0] * xv[i][0] + xv[i][1] * xv[i][1] + xv[i][2] * xv[i][2] + xv[i][3] * xv[i][3]; }
    ss = wave_sum(ss);
    const float rstd = rsqrtf(ss * (1.0f / DM) + EPS);
    float ga[8];
#pragma unroll
    for (int j = 0; j < 8; ++j) ga[j] = 0.f;
    const float* mrow = mod + (l * 8 + bg) * 3072;
#pragma unroll
    for (int i = 0; i < 4; ++i) {
      const int col = 256 * i + 4 * lane;
      const f32x4 g = *(const f32x4*)(p.norm_g + l * DM + col), sh = *(const f32x4*)(mrow + col), sc = *(const f32x4*)(mrow + 1024 + col);
      float hv[4];
#pragma unroll
      for (int e = 0; e < 4; ++e) hv[e] = xv[i][e] * rstd * g[e] * (1.0f + sc[e]) + sh[e];
      u32x2 o; o[0] = pack2(hv[0], hv[1]); o[1] = pack2(hv[2], hv[3]);
      *(u32x2*)(H + (size_t)tl * DM + col) = o;
#pragma unroll
      for (int e = 0; e < 4; ++e) {
        const f32x4 w0 = *(const f32x4*)(wg + (col + e) * 8), w1 = *(const f32x4*)(wg + (col + e) * 8 + 4);
#pragma unroll
        for (int j = 0; j < 4; ++j) { ga[j] += hv[e] * w0[j]; ga[4 + j] += hv[e] * w1[j]; }
      }
    }
#pragma unroll
    for (int j = 0; j < 8; ++j) ga[j] = wave_sum(ga[j]);
    if (lane < 8) {
      float v = ga[0];
#pragma unroll
      for (int j = 1; j < 8; ++j) v = (lane == j) ? ga[j] : v;
      v += p.b_if[l * 8 + lane];
      const int hh = lane & 3;
      float* dst = (lane < 4) ? GI : GF;
      dst[(bl * 4 + hh) * 4096 + t] = v;
    }
  }
}

DI void gate_scan(const Params& p, int bh, float* sf) {
  const int tid = get_tid(), g = tid >> 3, j = tid & 7, t0 = tid * 16;
  unsigned char* ws = p.ws;
  const float* GI = (const float*)(ws + OFF_GI) + bh * 4096 + t0;
  const float* GF = (const float*)(ws + OFF_GF) + bh * 4096 + t0;
  float* s_cm = sf; float* s_bl = sf + 32; float* s_mp = sf + 64; float* s_mml = sf + 96;
  float a[16], b[16], cm[16];
#pragma unroll
  for (int q = 0; q < 4; ++q) {
    const f32x4 fv = *(const f32x4*)(GF + 4 * q), iv = *(const f32x4*)(GI + 4 * q);
#pragma unroll
    for (int e = 0; e < 4; ++e) { const float f = fv[e]; b[4 * q + e] = fminf(f, 0.f) - log1pf(__expf(-fabsf(f))); a[4 * q + e] = iv[e]; }
  }
  float s = 0.f;
#pragma unroll
  for (int k = 0; k < 16; ++k) { s += b[k]; b[k] = s; }
  float inc = s;
#pragma unroll
  for (int o = 1; o < 8; o <<= 1) { const float v = __shfl_up(inc, o, 8); if (j >= o) inc += v; }
  const float excl = inc - s;
  float m = -INFINITY;
#pragma unroll
  for (int k = 0; k < 16; ++k) { b[k] += excl; a[k] -= b[k]; m = fmaxf(m, a[k]); cm[k] = m; }
  float inc2 = m;
#pragma unroll
  for (int o = 1; o < 8; o <<= 1) { const float v = __shfl_up(inc2, o, 8); if (j >= o) inc2 = fmaxf(inc2, v); }
  float exm = __shfl_up(inc2, 1, 8);
  if (j == 0) exm = -INFINITY;
#pragma unroll
  for (int k = 0; k < 16; ++k) cm[k] = fmaxf(cm[k], exm);
  __syncthreads();
  if (j == 7) { s_cm[g] = cm[15]; s_bl[g] = b[15]; }
  __syncthreads();
  if (tid == 0) {
    float mp = 0.f;
    float* GDEC = (float*)(ws + OFF_GDEC) + bh * 32;
    for (int c = 0; c < 32; ++c) {
      s_mp[c] = mp;
      const float mml = fmaxf(mp, s_cm[c]);
      s_mml[c] = mml;
      GDEC[c] = __expf(mp - mml);
      mp = s_bl[c] + mml;
    }
  }
  __syncthreads();
  const float mp = s_mp[g], mml = s_mml[g];
  float* GA = (float*)(ws + OFF_GA) + bh * 4096 + t0;
  float* GMM = (float*)(ws + OFF_GMM) + bh * 4096 + t0;
  float* GWI = (float*)(ws + OFF_GWI) + bh * 4096 + t0;
  float* GEM = (float*)(ws + OFF_GEM) + bh * 4096 + t0;
  float* GWK = (float*)(ws + OFF_GWK) + bh * 4096 + t0;
#pragma unroll
  for (int q = 0; q < 4; ++q) {
    f32x4 va, vmm, vwi, vem, vwk;
#pragma unroll
    for (int e = 0; e < 4; ++e) {
      const int k = 4 * q + e;
      const float mm = fmaxf(mp, cm[k]);
      va[e] = a[k]; vmm[e] = mm; vwi[e] = __expf(mp - mm); vem[e] = __expf(-(b[k] + mm)); vwk[e] = __expf(a[k] - mml);
    }
    *(f32x4*)(GA + 4 * q) = va; *(f32x4*)(GMM + 4 * q) = vmm; *(f32x4*)(GWI + 4 * q) = vwi; *(f32x4*)(GEM + 4 * q) = vem; *(f32x4*)(GWK + 4 * q) = vwk;
  }
}

DI void inproj_tile(const Params& p, int l, int mt, int nt, bf16_t* sm) {
  unsigned char* ws = p.ws;
  const bf16_t* H = (const bf16_t*)(ws + OFF_H) + (size_t)mt * 128 * DM;
  const bf16_t* W = (const bf16_t*)(ws + OFF_WTIN) + ((size_t)l * NPK + (size_t)nt * 128) * 1024;
  const int n0 = nt * 128;
  bool tr = false; int dcol = 0; bf16_t* tb = nullptr;
  if (n0 < 2048) dcol = n0;
  else if (n0 < 4096) { tr = true; tb = (bf16_t*)(ws + OFF_VMT) + ((size_t)((mt >> 5) * 2048 + (n0 - 2048))) * 4096 + (mt & 31) * 128; }
  else if (n0 < 10240) dcol = n0 - 2048;
  else if (n0 < 11264) { tr = true; tb = (bf16_t*)(ws + OFF_VAT) + ((size_t)((mt >> 5) * 1024 + (n0 - 10240))) * 4096 + (mt & 31) * 128; }
  else dcol = n0 - 3072;
  f32x16 acc[2][2];
  acc_zero(acc);
  if (!tr) {
    gemm_core<false, true>(H, DM, W, 1024, 1024, acc, sm, nullptr, 0);
    bf16_t* dst = (bf16_t*)(ws + OFF_NAT) + (size_t)mt * 128 * NATW + dcol;
    for_quads(acc, [&](int ar, int br, int ii, float v0, float v1, float v2, float v3) {
      u32x2 o; o[0] = pack2(v0, v1); o[1] = pack2(v2, v3);
      *(u32x2*)(dst + (size_t)ar * NATW + br) = o;
    });
  } else {
    gemm_core<false, true>(W, 1024, H, DM, 1024, acc, sm, nullptr, 0);
    for_quads(acc, [&](int ar, int br, int ii, float v0, float v1, float v2, float v3) {
      u32x2 o; o[0] = pack2(v0, v1); o[1] = pack2(v2, v3);
      *(u32x2*)(tb + (size_t)ar * 4096 + br) = o;
    });
  }
}

DI void conv_item(const Params& p, int l, int idx, float* smf) {
  const int tid = get_tid(), cg = tid & 31, tg = tid >> 5;
  unsigned char* ws = p.ws;
  const int which = idx & 1, c = (idx >> 1) & 31, bh = idx >> 6, bl = bh >> 2, h = bh & 3;
  const int ch0 = which * 1024 + h * 256 + 8 * cg;
  float w[4][8], bias[8];
#pragma unroll
  for (int j = 0; j < 4; ++j) {
    const f32x4 a0 = *(const f32x4*)(p.conv_w + (l * 4 + j) * 2048 + ch0), a1 = *(const f32x4*)(p.conv_w + (l * 4 + j) * 2048 + ch0 + 4);
#pragma unroll
    for (int e = 0; e < 4; ++e) { w[j][e] = a0[e]; w[j][4 + e] = a1[e]; }
  }
  {
    const f32x4 a0 = *(const f32x4*)(p.conv_b + l * 2048 + ch0), a1 = *(const f32x4*)(p.conv_b + l * 2048 + ch0 + 4);
#pragma unroll
    for (int e = 0; e < 4; ++e) { bias[e] = a0[e]; bias[4 + e] = a1[e]; }
  }
  const int ts = c * 128 + 16 * tg;
  const bf16_t* src = (const bf16_t*)(ws + OFF_NAT) + (size_t)bl * 4096 * NATW + (which ? C_KM : C_QM) + h * 256 + 8 * cg;
  u32x4 raw[19];
#pragma unroll
  for (int i = 0; i < 19; ++i) {
    const int t = ts - 3 + i;
    if (t >= 0) raw[i] = *(const u32x4*)(src + (size_t)t * NATW);
    else raw[i] = (u32x4){0u, 0u, 0u, 0u};
  }
  bf16_t* OUT = (bf16_t*)(ws + (which ? OFF_KN : OFF_Q)) + (size_t)bl * 4096 * 1024 + h * 256 + 8 * cg;
  bf16_t* KT = (bf16_t*)(ws + OFF_KT) + (size_t)(bh * 256 + 8 * cg) * 4096 + ts;
  const float* GWK = (const float*)(ws + OFF_GWK) + bh * 4096 + ts;
  float nacc[8];
#pragma unroll
  for (int e = 0; e < 8; ++e) nacc[e] = 0.f;
  const float osc = which ? 0.0625f : 1.0f;
#pragma unroll
  for (int half = 0; half < 2; ++half) {
    float ks[8][8];
    f32x4 wk0, wk1;
    if (which) { wk0 = *(const f32x4*)(GWK + 8 * half); wk1 = *(const f32x4*)(GWK + 8 * half + 4); }
#pragma unroll
    for (int tt = 0; tt < 8; ++tt) {
      const int i = 8 * half + tt;
      float y[8];
#pragma unroll
      for (int q = 0; q < 4; ++q) {
        const unsigned r0 = raw[i][q], r1 = raw[i + 1][q], r2 = raw[i + 2][q], r3 = raw[i + 3][q];
        y[2 * q] = w[3][2 * q] * bflo(r3) + bias[2 * q] + w[0][2 * q] * bflo(r0) + w[1][2 * q] * bflo(r1) + w[2][2 * q] * bflo(r2);
        y[2 * q + 1] = w[3][2 * q + 1] * bfhi(r3) + bias[2 * q + 1] + w[0][2 * q + 1] * bfhi(r0) + w[1][2 * q + 1] * bfhi(r1) + w[2][2 * q + 1] * bfhi(r2);
      }
#pragma unroll
      for (int e = 0; e < 8; ++e) y[e] = siluf_(y[e]) * osc;
      u32x4 o; o[0] = pack2(y[0], y[1]); o[1] = pack2(y[2], y[3]); o[2] = pack2(y[4], y[5]); o[3] = pack2(y[6], y[7]);
      *(u32x4*)(OUT + (size_t)(ts + i) * 1024) = o;
      if (which) {
        const float wkv = tt < 4 ? wk0[tt & 3] : wk1[tt & 3];
#pragma unroll
        for (int e = 0; e < 8; ++e) { ks[tt][e] = y[e] * wkv; nacc[e] += ks[tt][e]; }
      }
    }
    if (which) {
#pragma unroll
      for (int e = 0; e < 8; ++e) {
        u32x4 o; o[0] = pack2(ks[0][e], ks[1][e]); o[1] = pack2(ks[2][e], ks[3][e]); o[2] = pack2(ks[4][e], ks[5][e]); o[3] = pack2(ks[6][e], ks[7][e]);
        *(u32x4*)(KT + (size_t)e * 4096 + 8 * half) = o;
      }
    }
  }
  if (which) {
    __syncthreads();
#pragma unroll
    for (int e = 0; e < 8; ++e) smf[tg * 256 + 8 * cg + e] = nacc[e];
    __syncthreads();
    float s = 0.f;
#pragma unroll
    for (int g = 0; g < 8; ++g) s += smf[g * 256 + tid];
    ((float*)(ws + OFF_NLOC))[(bh * 32 + c) * 256 + tid] = s;
  }
}

DI void state_chain(const Params& p, int idx, int rd, bf16_t* sm) {
  unsigned char* ws = p.ws;
  const int bh = idx >> 3, i2 = (idx >> 2) & 1, j4 = idx & 3, bl = bh >> 2, h = bh & 3;
  const bf16_t* VT = (const bf16_t*)(ws + OFF_VMT) + (size_t)(bl * 2048 + h * 512 + j4 * 128) * 4096;
  const bf16_t* KT = (const bf16_t*)(ws + OFF_KT) + (size_t)(bh * 256 + i2 * 128) * 4096;
  const float* GDEC = (const float*)(ws + OFF_GDEC) + bh * 32;
  bf16_t* dst0 = (bf16_t*)(ws + OFF_CST) + ((size_t)(bh * 32) * 512 + j4 * 128) * 256 + i2 * 128;
  f32x16 acc[2][2];
  acc_zero(acc);
  auto snap = [&](int c) {
    bf16_t* dst = dst0 + (size_t)c * 512 * 256;
    for_quads(acc, [&](int ar, int br, int ii, float v0, float v1, float v2, float v3) {
      u32x2 o; o[0] = pack2(v0, v1); o[1] = pack2(v2, v3);
      *(u32x2*)(dst + (size_t)ar * 256 + br) = o;
    });
  };
  gemm_core<false, true>(VT, 4096, KT, 4096, 31 * 128, acc, sm, nullptr, 0, [&](int kt) {
    if ((kt & 1) == 0) {
      const int c = kt >> 1;
      snap(c);
      const float dec = GDEC[c];
#pragma unroll
      for (int i = 0; i < 2; ++i)
#pragma unroll
        for (int j = 0; j < 2; ++j) acc[i][j] *= dec;
    }
  });
  snap(31);
  asm volatile("s_waitcnt vmcnt(0)" ::: "memory");
  __syncthreads();
  if (get_tid() == 0) {
    __builtin_amdgcn_fence(__ATOMIC_RELEASE, "agent");
    asm volatile("s_waitcnt vmcnt(0)" ::: "memory");
    __hip_atomic_fetch_add((unsigned*)(ws + OFF_CNT) + 256 + rd * 8 + bh, 1u, __ATOMIC_RELAXED, __HIP_MEMORY_SCOPE_AGENT);
  }
}

constexpr int LDP = 136;
DI void mlstm_out_item(const Params& p, int l, int idx, int rd, bf16_t* sm) {
  const int tid = get_tid(), lane = tid & 63, h5 = lane >> 5;
  unsigned char* ws = p.ws;
  const int bh = idx >> 5, c = idx & 31, bl = bh >> 2, h = bh & 3;
  const size_t tok0 = (size_t)bl * 4096 + c * 128;
  bf16_t* Ps = sm + CORE_SM;
  float* vec = (float*)(sm + CORE_SM + 128 * LDP);
  float *sa = vec, *smm = vec + 128, *swi = vec + 256, *sden = vec + 384, *ssq = vec + 512, *sn = vec + 640, *sgem = vec + 896;
  const bf16_t* Q = (const bf16_t*)(ws + OFF_Q) + tok0 * 1024 + h * 256;
  const bf16_t* KN = (const bf16_t*)(ws + OFF_KN) + tok0 * 1024 + h * 256;
  const float* GDEC = (const float*)(ws + OFF_GDEC) + bh * 32;
  const float* GEM = (const float*)(ws + OFF_GEM) + bh * 4096 + c * 128;
  if (tid == 0) {
    unsigned* dn = (unsigned*)(ws + OFF_CNT) + 256 + rd * 8 + bh;
    unsigned sp = 0;
    while (__hip_atomic_load(dn, __ATOMIC_RELAXED, __HIP_MEMORY_SCOPE_AGENT) < 8u) { __builtin_amdgcn_s_sleep(8); if (++sp > (1u << 22)) break; }
    __builtin_amdgcn_fence(__ATOMIC_ACQUIRE, "agent");
    asm volatile("s_waitcnt vmcnt(0)" ::: "memory");
  }
  __syncthreads();
  if (tid < 128) {
    sa[tid] = ((const float*)(ws + OFF_GA))[bh * 4096 + c * 128 + tid];
    smm[tid] = ((const float*)(ws + OFF_GMM))[bh * 4096 + c * 128 + tid];
    swi[tid] = ((const float*)(ws + OFF_GWI))[bh * 4096 + c * 128 + tid];
    sden[tid] = 0.f;
    ssq[tid] = 0.f;
    sgem[tid] = GEM[tid];
  }
  {
    float n = 0.f;
    const float* NL = (const float*)(ws + OFF_NLOC) + (size_t)bh * 32 * 256 + tid;
#pragma unroll 1
    for (int c0 = 0; c0 < c; c0 += 8) {
      float nv[8], dv[8];
#pragma unroll
      for (int q = 0; q < 8; ++q) { const int cc = c0 + q < c ? c0 + q : c - 1; nv[q] = NL[cc * 256]; dv[q] = GDEC[cc]; }
#pragma unroll
      for (int q = 0; q < 8; ++q) if (c0 + q < c) n = n * dv[q] + nv[q];
    }
    sn[tid] = n;
  }
  __syncthreads();
  {
    const int t = tid >> 1, half = tid & 1;
    const bf16_t* qr = Q + (size_t)t * 1024 + half * 128;
    float d = 0.f;
#pragma unroll 4
    for (int k = 0; k < 128; k += 8) {
      const u32x4 v = *(const u32x4*)(qr + k);
      const float* nn = sn + half * 128 + k;
      d += bflo(v[0]) * nn[0] + bfhi(v[0]) * nn[1] + bflo(v[1]) * nn[2] + bfhi(v[1]) * nn[3] + bflo(v[2]) * nn[4] + bfhi(v[2]) * nn[5] + bflo(v[3]) * nn[6] + bfhi(v[3]) * nn[7];
    }
    atomicAdd(&sden[t], swi[t] * d);
  }
  f32x16 acc[2][2];
  acc_zero(acc);
  gemm_core<false, false>(Q, 1024, KN, 1024, 256, acc, sm, nullptr, 0);
  {
    float psum[2] = {0.f, 0.f};
    const int w = tid >> 6, wm = w >> 1, r = lane & 31;
    for_quads(acc, [&](int ar, int br, int ii, float v0, float v1, float v2, float v3) {
      const float mt = smm[ar];
      const f32x4 av = *(const f32x4*)(sa + br);
      const float p0 = (br + 0 <= ar) ? v0 * __expf(av[0] - mt) : 0.f;
      const float p1 = (br + 1 <= ar) ? v1 * __expf(av[1] - mt) : 0.f;
      const float p2 = (br + 2 <= ar) ? v2 * __expf(av[2] - mt) : 0.f;
      const float p3 = (br + 3 <= ar) ? v3 * __expf(av[3] - mt) : 0.f;
      psum[ii] += (p0 + p1) + (p2 + p3);
      u32x2 o; o[0] = pack2(p0, p1); o[1] = pack2(p2, p3);
      *(u32x2*)(Ps + ar * LDP + br) = o;
    });
#pragma unroll
    for (int i = 0; i < 2; ++i) {
      float s = psum[i];
      s += __shfl_xor(s, 32);
      if (h5 == 0) atomicAdd(&sden[64 * wm + 32 * i + r], s);
    }
  }
  __syncthreads();
  const bf16_t* OMp = (const bf16_t*)(ws + OFF_NAT) + tok0 * NATW + C_OM + h * 512;
  const bf16_t* ZMp = (const bf16_t*)(ws + OFF_NAT) + tok0 * NATW + C_ZM + h * 512;
  bf16_t* HMp = (bf16_t*)(ws + OFF_HM) + tok0 * 2048 + h * 512;
  bf16_t* Ht = sm;
  const int row = tid >> 1, hf = tid & 1;
  float sq = 0.f;
#pragma unroll 1
  for (int j4 = 0; j4 < 4; ++j4) {
    acc_zero(acc);
    if (c > 0) {
      gemm_core<false, false>(Q, 1024, (const bf16_t*)(ws + OFF_CST) + ((size_t)(bh * 32 + c) * 512 + j4 * 128) * 256, 256, 256, acc, sm, nullptr, 0);
      for_quads(acc, [&](int ar, int br, int ii, float& v0, float& v1, float& v2, float& v3) { const float s = swi[ar]; v0 *= s; v1 *= s; v2 *= s; v3 *= s; });
    }
    gemm_core<true, false>(nullptr, 0, (const bf16_t*)(ws + OFF_VMT) + (size_t)(bl * 2048 + h * 512 + j4 * 128) * 4096 + c * 128, 4096, 128, acc, sm, Ps, LDP);
    __syncthreads();
    for_quads(acc, [&](int ar, int br, int ii, float v0, float v1, float v2, float v3) {
      const float den = 1.0f / fmaxf(fabsf(sden[ar]), sgem[ar]);
      u32x2 o; o[0] = pack2(v0 * den, v1 * den); o[1] = pack2(v2 * den, v3 * den);
      *(u32x2*)(Ht + ar * LDP + br) = o;
    });
    __syncthreads();
#pragma unroll
    for (int q = 0; q < 8; ++q) {
      const int dv0 = hf * 64 + q * 8;
      const u32x4 hv = *(const u32x4*)(Ht + row * LDP + dv0);
      const u32x4 ov = *(const u32x4*)(OMp + (size_t)row * NATW + j4 * 128 + dv0);
      const u32x4 zv = *(const u32x4*)(ZMp + (size_t)row * NATW + j4 * 128 + dv0);
      const f32x4 g0 = *(const f32x4*)(p.mnorm_g + l * 2048 + h * 512 + j4 * 128 + dv0), g1 = *(const f32x4*)(p.mnorm_g + l * 2048 + h * 512 + j4 * 128 + dv0 + 4);
      u32x4 o;
#pragma unroll
      for (int e = 0; e < 4; ++e) {
        const float x0 = bflo(hv[e]) * sigmoidf_(bflo(ov[e])), x1 = bfhi(hv[e]) * sigmoidf_(bfhi(ov[e]));
        sq += x0 * x0 + x1 * x1;
        const float ga = e < 2 ? g0[2 * e] : g1[2 * e - 4], gb = e < 2 ? g0[2 * e + 1] : g1[2 * e - 3];
        o[e] = pack2(x0 * ga * siluf_(bflo(zv[e])), x1 * gb * siluf_(bfhi(zv[e])));
      }
      *(u32x4*)(HMp + (size_t)row * 2048 + j4 * 128 + dv0) = o;
    }
  }
  sq += __shfl_xor(sq, 1);
  if (hf == 0) ((float*)(ws + OFF_RS))[(tok0 + row) * 4 + h] = rsqrtf(sq * (1.0f / 512.0f) + EPS);
}

#define MFMA16(a, b, c) __builtin_amdgcn_mfma_f32_16x16x32_bf16((a), (b), (c), 0, 0, 0)
DI void attn_item(const Params& p, int l, int bl, int hd, int qb, bf16_t* sm) {
  const int tid = get_tid(), lane = tid & 63, w = tid >> 6, r16 = lane & 15, q4 = lane >> 4;
  unsigned char* ws = p.ws;
  bf16_t* Ks = sm;
  bf16_t* Vs = sm + 2 * 64 * LDT;
  float* tb = (float*)(sm + 2 * 64 * LDT + 128 * LDT);
  const bf16_t* NAT = (const bf16_t*)(ws + OFF_NAT) + (size_t)bl * 4096 * NATW;
  const bf16_t* VT = (const bf16_t*)(ws + OFF_VAT) + (size_t)(bl * 1024 + hd * 128) * 4096;
  const int wu = __builtin_amdgcn_readfirstlane(w);
  const int Q0 = qb * 64, t0 = Q0 + 16 * wu, t = t0 + r16;
  float lam;
  {
    float s1 = 0.f, s2 = 0.f;
    for (int i = 0; i < 64; ++i) { s1 += p.lam_q1[l * 64 + i] * p.lam_k1[l * 64 + i]; s2 += p.lam_q2[l * 64 + i] * p.lam_k2[l * 64 + i]; }
    lam = __expf(s1) - __expf(s2) + (l == 0 ? 0.2f : 0.35550906f);
  }
  const float oml = (l == 0) ? 0.8f : 0.64449094f;
  __syncthreads();
  if (tid < 129) {
    int bucket;
    if (tid < 16) bucket = tid;
    else { const float v = logf((float)tid / 16.0f) / 2.0794415416798357f * 16.0f; bucket = 16 + (int)v; if (bucket > 31) bucket = 31; }
    tb[tid] = p.rel_bias[bucket * 8 + hd] * LOG2E;
  }
  bf16_t* Qs = sm + 2 * 64 * LDT + 128 * LDT + 512;
#pragma unroll
  for (int pp = 0; pp < 4; ++pp) {
    const int id = tid + 256 * pp, row = id >> 4, ch = id & 15;
    *(u32x4*)(Qs + row * LDP + ch * 8) = *(const u32x4*)(NAT + (size_t)(Q0 + row) * NATW + C_QA + hd * 128 + ch * 8);
  }
  f32x4 O[2][8];
#pragma unroll
  for (int m = 0; m < 2; ++m)
#pragma unroll
    for (int jd = 0; jd < 8; ++jd)
#pragma unroll
      for (int e = 0; e < 4; ++e) O[m][jd][e] = 0.f;
  float Mx[2] = {-INFINITY, -INFINITY}, Ls[2] = {0.f, 0.f};
  const int ntile = qb + 1;
  const float c1 = 0.125f * LOG2E;
  u32x4 rk[4], rv[4];
#pragma unroll
  for (int pp = 0; pp < 4; ++pp) {
    const int id = tid + 256 * pp;
    rk[pp] = *(const u32x4*)(NAT + (size_t)((id >> 3) & 63) * NATW + C_KA + hd * 128 + (id >> 9) * 64 + (id & 7) * 8);
    rv[pp] = *(const u32x4*)(VT + (size_t)(id >> 3) * 4096 + (id & 7) * 8);
  }
#pragma unroll 1
  for (int kt = 0; kt < ntile; ++kt) {
    const int s0 = kt * 64;
    __syncthreads();
#pragma unroll
    for (int pp = 0; pp < 4; ++pp) {
      const int id = tid + 256 * pp;
      *(u32x4*)(Ks + ((id >> 9) * 64 + ((id >> 3) & 63)) * LDT + (id & 7) * 8) = rk[pp];
      *(u32x4*)(Vs + (id >> 3) * LDT + (id & 7) * 8) = rv[pp];
    }
    __syncthreads();
    if (kt + 1 < ntile) {
#pragma unroll
      for (int pp = 0; pp < 4; ++pp) {
        const int id = tid + 256 * pp;
        rk[pp] = *(const u32x4*)(NAT + (size_t)(s0 + 64 + ((id >> 3) & 63)) * NATW + C_KA + hd * 128 + (id >> 9) * 64 + (id & 7) * 8);
        rv[pp] = *(const u32x4*)(VT + (size_t)(id >> 3) * 4096 + s0 + 64 + (id & 7) * 8);
      }
    }
    if (s0 <= t0 + 15) {
      const bool nearb = (s0 + 63 + 128 > t0);
      const float tb128 = tb[128];
      u32x4 pk[2][2];
#pragma unroll
      for (int m = 0; m < 2; ++m) {
        f32x4 sacc[4];
#pragma unroll
        for (int st = 0; st < 4; ++st) {
#pragma unroll
          for (int e = 0; e < 4; ++e) sacc[st][e] = 0.f;
#pragma unroll
          for (int kk = 0; kk < 2; ++kk) {
            const bf16x8 a = *(const bf16x8*)(Ks + (m * 64 + 16 * st + r16) * LDT + kk * 32 + 8 * q4);
            const bf16x8 qfr = *(const bf16x8*)(Qs + (16 * wu + r16) * LDP + m * 64 + kk * 32 + 8 * q4);
            sacc[st] = MFMA16(a, qfr, sacc[st]);
          }
        }
        float alpha, ps = 0.f;
        if (!nearb) {
          float mx = fmaxf(fmaxf(sacc[0][0], sacc[0][1]), fmaxf(sacc[0][2], sacc[0][3]));
#pragma unroll
          for (int st = 1; st < 4; ++st) mx = fmaxf(mx, fmaxf(fmaxf(sacc[st][0], sacc[st][1]), fmaxf(sacc[st][2], sacc[st][3])));
          float Mn = Mx[m];
          alpha = 1.0f;
          if (__builtin_amdgcn_ballot_w64(mx * c1 + tb128 - Mn > 8.0f) != 0ull) {
            mx = fmaxf(mx, __shfl_xor(mx, 16));
            mx = fmaxf(mx, __shfl_xor(mx, 32));
            Mn = fmaxf(Mn, mx * c1 + tb128); alpha = __builtin_amdgcn_exp2f(Mx[m] - Mn); Mx[m] = Mn;
          }
          const float off = tb128 - Mn;
#pragma unroll
          for (int st = 0; st < 4; ++st)
#pragma unroll
            for (int e = 0; e < 4; ++e) { const float pv = __builtin_amdgcn_exp2f(sacc[st][e] * c1 + off); sacc[st][e] = pv; ps += pv; }
        } else {
          float mx = -INFINITY;
#pragma unroll
          for (int st = 0; st < 4; ++st)
#pragma unroll
            for (int e = 0; e < 4; ++e) {
              const int s = s0 + 16 * st + 4 * q4 + e;
              const int rel = t - s;
              int ri = rel < 0 ? 0 : rel; ri = ri > 128 ? 128 : ri;
              float xv = sacc[st][e] * c1 + tb[ri];
              if (rel < 0) xv = -INFINITY;
              sacc[st][e] = xv;
              mx = fmaxf(mx, xv);
            }
          float Mn = Mx[m];
          alpha = 1.0f;
          if (__builtin_amdgcn_ballot_w64(mx - Mn > 8.0f) != 0ull) {
            mx = fmaxf(mx, __shfl_xor(mx, 16));
            mx = fmaxf(mx, __shfl_xor(mx, 32));
            Mn = fmaxf(Mn, mx); alpha = __builtin_amdgcn_exp2f(Mx[m] - Mn); Mx[m] = Mn;
          }
#pragma unroll
          for (int st = 0; st < 4; ++st)
#pragma unroll
            for (int e = 0; e < 4; ++e) { const float pv = __builtin_amdgcn_exp2f(sacc[st][e] - Mn); sacc[st][e] = pv; ps += pv; }
        }
        Ls[m] = Ls[m] * alpha + ps;
        if (__builtin_amdgcn_ballot_w64(alpha != 1.0f) != 0ull) {
#pragma unroll
          for (int jd = 0; jd < 8; ++jd) O[m][jd] *= alpha;
        }
#pragma unroll
        for (int u = 0; u < 2; ++u) {
          pk[m][u][0] = pack2(sacc[2 * u][0], sacc[2 * u][1]); pk[m][u][1] = pack2(sacc[2 * u][2], sacc[2 * u][3]);
          pk[m][u][2] = pack2(sacc[2 * u + 1][0], sacc[2 * u + 1][1]); pk[m][u][3] = pack2(sacc[2 * u + 1][2], sacc[2 * u + 1][3]);
        }
        __builtin_amdgcn_sched_barrier(0);
      }
#pragma unroll
      for (int u = 0; u < 2; ++u) {
        const bf16x8 pf0 = __builtin_bit_cast(bf16x8, pk[0][u]), pf1 = __builtin_bit_cast(bf16x8, pk[1][u]);
#pragma unroll
        for (int jd = 0; jd < 8; ++jd) {
          if ((jd & 3) == 0) asm volatile("" ::: "memory");
          const bf16_t* vp = Vs + (16 * jd + r16) * LDT + 32 * u + 4 * q4;
          const s16x4 lo = *(const s16x4*)vp, hi = *(const s16x4*)(vp + 16);
          const bf16x8 vf = __builtin_shufflevector(lo, hi, 0, 1, 2, 3, 4, 5, 6, 7);
          O[0][jd] = MFMA16(vf, pf0, O[0][jd]);
          O[1][jd] = MFMA16(vf, pf1, O[1][jd]);
        }
      }
    }
  }
  float L1 = Ls[0], L2 = Ls[1];
  L1 += __shfl_xor(L1, 16); L1 += __shfl_xor(L1, 32);
  L2 += __shfl_xor(L2, 16); L2 += __shfl_xor(L2, 32);
  const float i1 = 1.0f / L1, i2 = lam / L2;
  float ss = 0.f;
#pragma unroll
  for (int jd = 0; jd < 8; ++jd)
#pragma unroll
    for (int e = 0; e < 4; ++e) { const float o = O[0][jd][e] * i1 - O[1][jd][e] * i2; O[0][jd][e] = o; ss += o * o; }
  ss += __shfl_xor(ss, 16); ss += __shfl_xor(ss, 32);
  const float rs = rsqrtf(ss * (1.0f / 128.0f) + EPS) * oml;
  const bf16_t* ZA = NAT + (size_t)t * NATW + C_ZA + hd * 128;
  bf16_t* HA = (bf16_t*)(ws + OFF_HA) + ((size_t)bl * 4096 + t) * 1024 + hd * 128;
  const float* ag = p.anorm_g + l * 1024 + hd * 128;
#pragma unroll
  for (int jd = 0; jd < 8; ++jd) {
    const int dv = 16 * jd + 4 * q4;
    const u32x2 zv = *(const u32x2*)(ZA + dv);
    const f32x4 gg = *(const f32x4*)(ag + dv);
    u32x2 o;
    o[0] = pack2(O[0][jd][0] * rs * gg[0] * siluf_(bflo(zv[0])), O[0][jd][1] * rs * gg[1] * siluf_(bfhi(zv[0])));
    o[1] = pack2(O[0][jd][2] * rs * gg[2] * siluf_(bflo(zv[1])), O[0][jd][3] * rs * gg[3] * siluf_(bfhi(zv[1])));
    *(u32x2*)(HA + dv) = o;
  }
}

DI void proj_tile(const Params& p, int l, int mt, int nt, bf16_t* sm) {
  unsigned char* ws = p.ws;
  f32x16 acc[2][2];
  acc_zero(acc);
  f32x4 rsv[2];
  {
    const int lane_ = get_tid() & 63, w_ = get_tid() >> 6;
#pragma unroll
    for (int i = 0; i < 2; ++i) rsv[i] = *(const f32x4*)((const float*)(ws + OFF_RS) + ((size_t)mt * 128 + 64 * (w_ >> 1) + 32 * i + (lane_ & 31)) * 4);
  }
  gemm_core<false, true>((const bf16_t*)(ws + OFF_HM) + (size_t)mt * 128 * 2048, 2048, (const bf16_t*)(ws + OFF_WTPM) + ((size_t)l * 1024 + nt * 128) * 2048, 2048, 2048, acc, sm, nullptr, 0, [&](int kt) {
    if (kt == 8) {
#pragma unroll
      for (int i = 0; i < 2; ++i) { const float f = rsv[i][0] / rsv[i][1]; acc[i][0] *= f; acc[i][1] *= f; }
    } else if (kt == 16) {
#pragma unroll
      for (int i = 0; i < 2; ++i) { const float f = rsv[i][1] / rsv[i][2]; acc[i][0] *= f; acc[i][1] *= f; }
    } else if (kt == 24) {
#pragma unroll
      for (int i = 0; i < 2; ++i) { const float f = rsv[i][2] / rsv[i][3]; acc[i][0] *= f; acc[i][1] *= f; }
    }
  });
#pragma unroll
  for (int i = 0; i < 2; ++i) { acc[i][0] *= rsv[i][3]; acc[i][1] *= rsv[i][3]; }
  const bf16_t* G = (const bf16_t*)(ws + OFF_NAT) + (size_t)mt * 128 * NATW + nt * 128;
  for_quads(acc, [&](int ar, int br, int ii, float& v0, float& v1, float& v2, float& v3) {
    const u32x2 gm = *(const u32x2*)(G + (size_t)ar * NATW + C_GM + br), ga = *(const u32x2*)(G + (size_t)ar * NATW + C_GA + br);
    v0 *= (1.0f + __expf(-bflo(ga[0]))) / (1.0f + __expf(-bflo(gm[0])));
    v1 *= (1.0f + __expf(-bfhi(ga[0]))) / (1.0f + __expf(-bfhi(gm[0])));
    v2 *= (1.0f + __expf(-bflo(ga[1]))) / (1.0f + __expf(-bflo(gm[1])));
    v3 *= (1.0f + __expf(-bfhi(ga[1]))) / (1.0f + __expf(-bfhi(gm[1])));
  });
  gemm_core<false, true>((const bf16_t*)(ws + OFF_HA) + (size_t)mt * 128 * 1024, 1024, (const bf16_t*)(ws + OFF_WTPA) + ((size_t)l * 1024 + nt * 128) * 1024, 1024, 1024, acc, sm, nullptr, 0);
  bf16_t* Y = (bf16_t*)(ws + OFF_Q) + (size_t)mt * 128 * 1024 + nt * 128;
  for_quads(acc, [&](int ar, int br, int ii, float v0, float v1, float v2, float v3) {
    const u32x2 ga = *(const u32x2*)(G + (size_t)ar * NATW + C_GA + br);
    u32x2 o;
    o[0] = pack2(v0 * sigmoidf_(bflo(ga[0])), v1 * sigmoidf_(bfhi(ga[0])));
    o[1] = pack2(v2 * sigmoidf_(bflo(ga[1])), v3 * sigmoidf_(bfhi(ga[1])));
    *(u32x2*)(Y + (size_t)ar * 1024 + br) = o;
  });
}

DI void out_tile(const Params& p, int l, int grp, int mt, int nt, bf16_t* sm) {
  unsigned char* ws = p.ws;
  f32x16 acc[2][2];
  acc_zero(acc);
  gemm_core<false, true>((const bf16_t*)(ws + OFF_Q) + (size_t)mt * 128 * 1024, 1024, (const bf16_t*)(ws + OFF_WTOUT) + ((size_t)l * 1024 + nt * 128) * 1024, 1024, 1024, acc, sm, nullptr, 0);
  const float* xin = ((l == 0) ? p.x : p.out) + ((size_t)grp * TOK + mt * 128) * DM + nt * 128;
  float* xo = p.out + ((size_t)grp * TOK + mt * 128) * DM + nt * 128;
  const float* gate = (const float*)(ws + OFF_MOD) + (l * 8 + grp * 2 + (mt >> 5)) * 3072 + 2048 + nt * 128;
  for_quads(acc, [&](int ar, int br, int ii, float v0, float v1, float v2, float v3) {
    const f32x4 xv = *(const f32x4*)(xin + (size_t)ar * DM + br);
    const f32x4 gv = *(const f32x4*)(gate + br);
    f32x4 o; o[0] = xv[0] + gv[0] * v0; o[1] = xv[1] + gv[1] * v1; o[2] = xv[2] + gv[2] * v2; o[3] = xv[3] + gv[3] * v3;
    *(f32x4*)(xo + (size_t)ar * DM + br) = o;
  });
}

DI void final_norm(const Params& p) {
  const int tid = get_tid(), lane = tid & 63, w = tid >> 6;
  for (int it = blockIdx.x; it < NBATCH * SEQ / 4; it += gridDim.x) {
    float* xr = p.out + ((size_t)it * 4 + w) * DM;
    f32x4 xv[4];
    float ss = 0.f;
#pragma unroll
    for (int i = 0; i < 4; ++i) { xv[i] = *(const f32x4*)(xr + 256 * i + 4 * lane); ss += xv[i][0] * xv[i][0] + xv[i][1] * xv[i][1] + xv[i][2] * xv[i][2] + xv[i][3] * xv[i][3]; }
    ss = wave_sum(ss);
    const float rstd = rsqrtf(ss * (1.0f / DM) + EPS);
#pragma unroll
    for (int i = 0; i < 4; ++i) {
      const f32x4 g = *(const f32x4*)(p.final_g + 256 * i + 4 * lane);
      f32x4 o; o[0] = xv[i][0] * rstd * g[0]; o[1] = xv[i][1] * rstd * g[1]; o[2] = xv[i][2] * rstd * g[2]; o[3] = xv[i][3] * rstd * g[3];
      *(f32x4*)(xr + 256 * i + 4 * lane) = o;
    }
  }
}


#define XB_TMO      128
#define XB_XCNT(j)  (256  + 64 * (j))
#define XB_XSUB(j)  (1280 + 64 * (j))
#define XB_XGEN(j)  (2304 + 64 * (j))
#define XB_TOP      3328
#define XB_TOPGEN   3392
#define XCD_BAR_WORDS 3456
#define XB_SPIN_CAP (1u << 22)
#define LAS __attribute__((address_space(3)))
DI unsigned xb_ld(unsigned* p) { return __hip_atomic_load(p, __ATOMIC_RELAXED, __HIP_MEMORY_SCOPE_AGENT); }
DI unsigned xb_add(unsigned* p, unsigned v) { return __hip_atomic_fetch_add(p, v, __ATOMIC_RELAXED, __HIP_MEMORY_SCOPE_AGENT); }
DI unsigned xb_xcc_id() { return (unsigned)__builtin_amdgcn_s_getreg((3 << 11) | 20) & 0xFu; }
#define XB_SPIN(cond, bar) do { unsigned _sp = 0; while (cond) { __builtin_amdgcn_s_sleep(1); \
    if ((++_sp & 255u) == 0u) { if (xb_ld(&(bar)[XB_TMO])) break; if (_sp > XB_SPIN_CAP) { atomicAdd(&(bar)[XB_TMO], 1u); break; } } } } while (0)
struct XcdBarrier { unsigned* bar; unsigned x; volatile LAS unsigned* st; };
DI XcdBarrier xcd_barrier_post(unsigned* bar, volatile LAS unsigned* st) {
  XcdBarrier b; b.bar = bar; b.x = xb_xcc_id(); b.st = st;
  if (threadIdx.x == 0) (void)xb_add(&bar[XB_XCNT(b.x)], 1u);
  return b;
}
DI void xcd_barrier_complete(unsigned* bar, unsigned x, unsigned& nloc, unsigned& nx) {
  const unsigned G = gridDim.x * gridDim.y * gridDim.z;
  unsigned sum, cnt, mine, sp = 0u;
  for (;;) {
    sum = 0u; cnt = 0u; mine = 0u;
#pragma unroll
    for (unsigned j = 0; j < 16; ++j) { const unsigned c = xb_ld(&bar[XB_XCNT(j)]); sum += c; cnt += (c > 0u) ? 1u : 0u; mine = (j == x) ? c : mine; }
    if (sum == G) break;
    __builtin_amdgcn_s_sleep(1);
    if ((++sp & 255u) == 0u) { if (xb_ld(&bar[XB_TMO])) break; if (sp > XB_SPIN_CAP) { atomicAdd(&bar[XB_TMO], 1u); break; } }
  }
  nloc = mine > 0u ? mine : 1u; nx = cnt > 0u ? cnt : 1u;
}
DI void xcd_barrier(const XcdBarrier& b) {
  asm volatile("s_waitcnt vmcnt(0)" ::: "memory");
  __syncthreads();
  if (threadIdx.x == 0) {
    unsigned* bar = b.bar;
    __builtin_amdgcn_s_waitcnt(0);
    unsigned nloc = b.st[0], nx = b.st[1];
    if (nloc == 0u) { xcd_barrier_complete(bar, b.x, nloc, nx); b.st[0] = nloc; b.st[1] = nx; }
    const unsigned old = xb_add(&bar[XB_XSUB(b.x)], 1u);
    const unsigned gen = old / nloc;
    if (old + 1u == (gen + 1u) * nloc) {
      __builtin_amdgcn_fence(__ATOMIC_RELEASE, "agent");
      asm volatile("s_waitcnt vmcnt(0)" ::: "memory");
      const unsigned og = xb_add(&bar[XB_TOP], 1u);
      const unsigned tg = og / nx;
      if (og + 1u == (tg + 1u) * nx) xb_add(&bar[XB_TOPGEN], 1u);
      else XB_SPIN(xb_ld(&bar[XB_TOPGEN]) == tg, bar);
      __builtin_amdgcn_fence(__ATOMIC_ACQUIRE, "agent");
      xb_add(&bar[XB_XGEN(b.x)], 1u);
      asm volatile("s_waitcnt vmcnt(0)" ::: "memory");
    } else {
      XB_SPIN(xb_ld(&bar[XB_XGEN(b.x)]) == gen, bar);
      __builtin_amdgcn_fence(__ATOMIC_ACQUIRE, "agent");
      asm volatile("s_waitcnt vmcnt(0)" ::: "memory");
    }
  }
  __syncthreads();
}

constexpr int SMEM_BYTES = (CORE_SM + 128 * LDP) * 2 + 1024 * 4;

__global__ void __launch_bounds__(256, 2) fwd_megakernel(Params p) {
  cg::grid_group grid = cg::this_grid();
#define GSYNC() xcd_barrier(xb)
  extern __shared__ __attribute__((aligned(16))) unsigned char smem_raw[];
  bf16_t* sm = (bf16_t*)smem_raw;
  __shared__ __attribute__((aligned(16))) unsigned s_static[8];
#define s_item (*(volatile int*)&s_static[4])
  const int tid = get_tid();
  int* cnt = (int*)(p.ws + OFF_CNT);
#ifdef PROBE_SEL_A
  float tacc[8] = {0.f, 0.f, 0.f, 0.f, 0.f, 0.f, 0.f, 0.f};
  unsigned long long tlast = wall_clock64();
#define TS(k) { const unsigned long long now_ = wall_clock64(); tacc[k] += (float)(now_ - tlast); tlast = now_; }
#elif defined(PROBE_AMP)
  unsigned long long tlast = wall_clock64();
#define TS(k) { if (blockIdx.x == 0) { const unsigned long long now_ = wall_clock64(); if ((k) == PROBE_AMP) { const unsigned long long dt_ = now_ - tlast; while (wall_clock64() - now_ < 4ull * dt_) __builtin_amdgcn_s_sleep(16); } tlast = wall_clock64(); } }
#else
#define TS(k)
#endif

  if (threadIdx.x < 8) s_static[threadIdx.x] = 0u;
  __syncthreads();
  XcdBarrier xb = xcd_barrier_post((unsigned*)(p.ws + OFF_BAR), (volatile LAS unsigned*)s_static);
  phase0(p, (float*)smem_raw);
#ifdef DBL_P0
  phase0(p, (float*)smem_raw);
#endif
  grid.sync();
  norm_rows(p, 0, 0, blockIdx.x, gridDim.x);
  GSYNC();
  TS(0)

  for (int rd = 0; rd < 8; ++rd) {
    const int l = rd >> 2;
    if (blockIdx.x < 8) gate_scan(p, blockIdx.x, (float*)smem_raw);
    if (rd > 0) for (int it = blockIdx.x; it < 512; it += gridDim.x) out_tile(p, (rd - 1) >> 2, (rd - 1) & 3, it & 63, it >> 6, sm);
#ifdef DBL_B
    for (int rep = 0; rep < 2; ++rep)
#endif
    for (int it = blockIdx.x; it < 64 * 112; it += gridDim.x) inproj_tile(p, l, it & 63, it >> 6, sm);
    GSYNC();
    TS(1)
#ifdef DBL_CONV
    for (int rep = 0; rep < 2; ++rep)
#endif
    for (int it = blockIdx.x; it < 512; it += gridDim.x) conv_item(p, l, it, (float*)smem_raw);
    if (rd < 7) norm_rows(p, (rd + 1) >> 2, (rd + 1) & 3, blockIdx.x, gridDim.x);
    GSYNC();
    TS(2)
#ifdef DBL_C1
    for (int rep = 0; rep < 2; ++rep)
#else
    const int rep = 0;
#endif
    for (;;) {
      const int rdx = rd + 8 * rep;
      __syncthreads();
      if (tid == 0) s_item = atomicAdd(&cnt[rdx * 16], 1);
      __syncthreads();
      const int it = s_item;
      if (it >= 64 + 1024 + 256) break;
      if (it < 64) state_chain(p, it, rdx, sm);
      else if (it < 448 || it >= 704) {
        int k, qb;
        if (it < 448) { k = it - 64; qb = 63 - (k >> 4); }
        else { k = it - 704; qb = 39 - (k >> 4); }
        attn_item(p, l, (k >> 3) & 1, k & 7, qb, sm);
      } else mlstm_out_item(p, l, it - 448, rdx, sm);
    }
    GSYNC();
    TS(4)
#ifdef DBL_PROJ
    for (int rep = 0; rep < 2; ++rep)
#endif
    for (int it = blockIdx.x; it < 512; it += gridDim.x) proj_tile(p, l, it & 63, it >> 6, sm);
    GSYNC();
    TS(5)
  }
  for (int it = blockIdx.x; it < 512; it += gridDim.x) out_tile(p, 1, 3, it & 63, it >> 6, sm);
  GSYNC();
  TS(6)
  final_norm(p);
#ifdef PROBE_SEL_A
  TS(7)
  __syncthreads();
  if (blockIdx.x == 0 && tid == 0) { p.out[0] += tacc[PROBE_SEL_A] * 0.01f; p.out[1] += tacc[PROBE_SEL_B] * 0.01f; }
#endif
}

extern "C" void kernel_launch(void* const* d_in, const int* in_sizes, int n_in, void* d_out, int out_size, void* d_ws, size_t ws_size, hipStream_t stream) {
  static int grid_blocks = 0;
  if (!grid_blocks) {
    int dev = 0, cus = 0, per_cu = 0;
    hipGetDevice(&dev);
    hipDeviceGetAttribute(&cus, hipDeviceAttributeMultiprocessorCount, dev);
    hipFuncSetAttribute((const void*)fwd_megakernel, hipFuncAttributeMaxDynamicSharedMemorySize, SMEM_BYTES);
    hipOccupancyMaxActiveBlocksPerMultiprocessor(&per_cu, (const void*)fwd_megakernel, 256, SMEM_BYTES);
    if (per_cu < 1) per_cu = 1;
    if (per_cu > 2) per_cu = 2;
    grid_blocks = cus * per_cu;
    if (ws_size < WS_END) fprintf(stderr, "kernel_launch: workspace too small: %zu < %zu\n", ws_size, (size_t)WS_END);
  }
  Params p{};
  const float** pp = (const float**)&p;
  for (int i = 0; i < 20; ++i) pp[i] = (const float*)d_in[i];
  p.out = (float*)d_out;
  p.ws = (unsigned char*)d_ws;
  hipMemsetAsync(d_ws, 0, 20480, stream);
  void* args[] = {&p};
  hipError_t e = hipLaunchCooperativeKernel((const void*)fwd_megakernel, dim3(grid_blocks), dim3(256), args, SMEM_BYTES, stream);
  if (e != hipSuccess) fprintf(stderr, "cooperative launch failed: %s (grid %d)\n", hipGetErrorString(e), grid_blocks);
}
```

```cpp
#include <hip/hip_runtime.h>
#define SGB 1
#include <hip/hip_cooperative_groups.h>
#include <cstdio>
#include <cstdint>
namespace cg = cooperative_groups;

typedef unsigned short bf16_t;
typedef short bf16x8 __attribute__((ext_vector_type(8)));
typedef short s16x4 __attribute__((ext_vector_type(4)));
typedef float f32x16 __attribute__((ext_vector_type(16)));
typedef float f32x4 __attribute__((ext_vector_type(4)));
typedef unsigned u32x4 __attribute__((ext_vector_type(4)));
typedef unsigned u32x2 __attribute__((ext_vector_type(2)));
#define DI __device__ __forceinline__
#define MFMA32(a, b, c) __builtin_amdgcn_mfma_f32_32x32x16_bf16((a), (b), (c), 0, 0, 0)

constexpr int DM = 1024, SEQ = 4096, NBATCH = 8, TOK = 8192  , NIN = 14344, NPK = 14336, NATW = 11264;
constexpr int C_QM = 0, C_KM = 1024, C_OM = 2048, C_ZM = 4096, C_QA = 6144, C_KA = 7168, C_ZA = 8192, C_GM = 9216, C_GA = 10240;
constexpr float EPS = 1e-6f, LOG2E = 1.4426950408889634f;

constexpr size_t al256(size_t x) { return (x + 255) & ~(size_t)255; }
constexpr size_t OFF_CNT = 0;
constexpr size_t OFF_BAR = 4096;
constexpr size_t OFF_MOD = 20480;
constexpr size_t OFF_WG = OFF_MOD + al256(2 * 8 * 3072 * 4);
constexpr size_t OFF_GI = OFF_WG + al256(2 * 1024 * 8 * 4);
constexpr size_t OFF_GF = OFF_GI + 131072;
constexpr size_t OFF_GA = OFF_GF + 131072;
constexpr size_t OFF_GMM = OFF_GA + 131072;
constexpr size_t OFF_GWI = OFF_GMM + 131072;
constexpr size_t OFF_GEM = OFF_GWI + 131072;
constexpr size_t OFF_GWK = OFF_GEM + 131072;
constexpr size_t OFF_GDEC = OFF_GWK + 131072;
constexpr size_t OFF_NLOC = OFF_GDEC + 1024;
constexpr size_t OFF_WTIN = OFF_NLOC + 262144;
constexpr size_t OFF_WTPM = OFF_WTIN + (size_t)2 * NPK * 1024 * 2;
constexpr size_t OFF_WTPA = OFF_WTPM + (size_t)2 * 1024 * 2048 * 2;
constexpr size_t OFF_WTOUT = OFF_WTPA + (size_t)2 * 1024 * 1024 * 2;
constexpr size_t OFF_H = OFF_WTOUT + (size_t)2 * 1024 * 1024 * 2;
constexpr size_t OFF_NAT = OFF_H + (size_t)TOK * 1024 * 2;
constexpr size_t OFF_VMT = OFF_NAT + (size_t)TOK * NATW * 2;
constexpr size_t OFF_VAT = OFF_VMT + (size_t)2 * 2048 * 4096 * 2;
constexpr size_t OFF_Q = OFF_VAT + (size_t)2 * 1024 * 4096 * 2;
constexpr size_t OFF_KN = OFF_Q + (size_t)TOK * 1024 * 2;
constexpr size_t OFF_KT = OFF_KN + (size_t)TOK * 1024 * 2;
constexpr size_t OFF_CST = OFF_KT + (size_t)TOK * 1024 * 2;
constexpr size_t OFF_HM = OFF_CST + (size_t)8 * 32 * 512 * 256 * 2;
constexpr size_t OFF_HA = OFF_HM + (size_t)TOK * 2048 * 2;
constexpr size_t OFF_RS = OFF_HA + (size_t)TOK * 1024 * 2;
constexpr size_t WS_END = OFF_RS + (size_t)TOK * 4 * 4;

struct Params {
  const float *x, *c, *norm_g, *w_ada, *b_ada, *w_in, *b_if, *conv_w, *conv_b, *mnorm_g, *w_proj_m, *lam_q1, *lam_k1, *lam_q2, *lam_k2, *anorm_g, *w_proj_a, *w_out, *rel_bias, *final_g;
  float* out;
  unsigned char* ws;
};

DI int get_tid() { int t = (int)__builtin_amdgcn_workitem_id_x(); asm volatile("" : "+v"(t)); return t; }
DI unsigned short f2bf(float x) { return __builtin_bit_cast(unsigned short, (__bf16)x); }
typedef __bf16 hbf2 __attribute__((ext_vector_type(2)));
typedef float f32x2 __attribute__((ext_vector_type(2)));
DI unsigned pack2(float a, float b) { f32x2 v = {a, b}; hbf2 r = __builtin_convertvector(v, hbf2); return __builtin_bit_cast(unsigned, r); }
DI float bflo(unsigned v) { return __uint_as_float(v << 16); }
DI float bfhi(unsigned v) { return __uint_as_float(v & 0xffff0000u); }
DI float sigmoidf_(float x) { return 1.0f / (1.0f + __expf(-x)); }
DI float siluf_(float x) { return x / (1.0f + __expf(-x)); }
DI float wave_sum(float v) {
#pragma unroll
  for (int o = 32; o > 0; o >>= 1) v += __shfl_xor(v, o);
  return v;
}

constexpr int LDT = 72;
constexpr int CORE_SM = 2 * 128 * LDT;
struct NoHook { DI void operator()(int) const {} };
template <bool A_LDS, bool DB, class Hook = NoHook>
DI void gemm_core(const bf16_t* __restrict__ A, int lda, const bf16_t* __restrict__ B, int ldb, int K, f32x16 (&acc)[2][2], bf16_t* sm,
                  const bf16_t* aL, int ldaL, Hook hook = Hook()) {
  const int tid = get_tid(), lane = tid & 63, w = tid >> 6, wm = w >> 1, wn = w & 1, r = lane & 31, h = lane >> 5;
  const int lr = tid >> 3, lc = (tid & 7) * 8;
  u32x4 ra[4], rb[4];
  const int nk = K >> 6;
#pragma unroll
  for (int p = 0; p < 4; ++p) {
    if (!A_LDS) ra[p] = *(const u32x4*)(A + (size_t)(lr + 32 * p) * lda + lc);
    rb[p] = *(const u32x4*)(B + (size_t)(lr + 32 * p) * ldb + lc);
  }
  if (DB) {
    __syncthreads();
#pragma unroll
    for (int p = 0; p < 4; ++p) {
      if (!A_LDS) *(u32x4*)(sm + (lr + 32 * p) * LDT + lc) = ra[p];
      *(u32x4*)(sm + 128 * LDT + (lr + 32 * p) * LDT + lc) = rb[p];
    }
    if (nk > 1) {
#pragma unroll
      for (int p = 0; p < 4; ++p) {
        if (!A_LDS) ra[p] = *(const u32x4*)(A + (size_t)(lr + 32 * p) * lda + 64 + lc);
        rb[p] = *(const u32x4*)(B + (size_t)(lr + 32 * p) * ldb + 64 + lc);
      }
    }
    __syncthreads();
  }
#pragma unroll 1
  for (int kt = 0; kt < nk; ++kt) {
    hook(kt);
    bf16_t* As;
    if (DB) {
      As = sm + (kt & 1) * CORE_SM;
      bf16_t* Nx = sm + ((kt + 1) & 1) * CORE_SM;
      if (kt + 1 < nk) {
#pragma unroll
        for (int p = 0; p < 4; ++p) {
          if (!A_LDS) *(u32x4*)(Nx + (lr + 32 * p) * LDT + lc) = ra[p];
          *(u32x4*)(Nx + 128 * LDT + (lr + 32 * p) * LDT + lc) = rb[p];
        }
      }
      if (kt + 2 < nk) {
        const int ko = (kt + 2) * 64 + lc;
#pragma unroll
        for (int p = 0; p < 4; ++p) {
          if (!A_LDS) ra[p] = *(const u32x4*)(A + (size_t)(lr + 32 * p) * lda + ko);
          rb[p] = *(const u32x4*)(B + (size_t)(lr + 32 * p) * ldb + ko);
        }
      }
    } else {
      As = sm;
      __syncthreads();
#pragma unroll
      for (int p = 0; p < 4; ++p) {
        if (!A_LDS) *(u32x4*)(As + (lr + 32 * p) * LDT + lc) = ra[p];
        *(u32x4*)(As + 128 * LDT + (lr + 32 * p) * LDT + lc) = rb[p];
      }
      __syncthreads();
      if (kt + 1 < nk) {
        const int ko = (kt + 1) * 64 + lc;
#pragma unroll
        for (int p = 0; p < 4; ++p) {
          if (!A_LDS) ra[p] = *(const u32x4*)(A + (size_t)(lr + 32 * p) * lda + ko);
          rb[p] = *(const u32x4*)(B + (size_t)(lr + 32 * p) * ldb + ko);
        }
      }
    }
    const bf16_t* Bs = As + 128 * LDT;
    __builtin_amdgcn_s_setprio(2);
#pragma unroll
    for (int kk = 0; kk < 4; ++kk) {
      bf16x8 af[2], bfr[2];
#pragma unroll
      for (int i = 0; i < 2; ++i) {
        if (A_LDS) af[i] = *(const bf16x8*)(aL + (64 * wm + 32 * i + r) * ldaL + kt * 64 + kk * 16 + 8 * h);
        else af[i] = *(const bf16x8*)(As + (64 * wm + 32 * i + r) * LDT + kk * 16 + 8 * h);
      }
#pragma unroll
      for (int j = 0; j < 2; ++j) bfr[j] = *(const bf16x8*)(Bs + (64 * wn + 32 * j + r) * LDT + kk * 16 + 8 * h);
#pragma unroll
      for (int i = 0; i < 2; ++i)
#pragma unroll
        for (int j = 0; j < 2; ++j) acc[i][j] = MFMA32(bfr[j], af[i], acc[i][j]);
    }
#ifdef SGB
    __builtin_amdgcn_sched_group_barrier(0x100, 4, 0);
#pragma unroll
    for (int q = 0; q < 12; ++q) { __builtin_amdgcn_sched_group_barrier(0x008, 1, 0); __builtin_amdgcn_sched_group_barrier(0x100, 1, 0); }
    __builtin_amdgcn_sched_group_barrier(0x008, 4, 0);
#endif
    __builtin_amdgcn_s_setprio(0);
    if (DB) __syncthreads();
  }
}

DI void acc_zero(f32x16 (&acc)[2][2]) {
#pragma unroll
  for (int i = 0; i < 2; ++i)
#pragma unroll
    for (int j = 0; j < 2; ++j)
#pragma unroll
      for (int e = 0; e < 16; ++e) acc[i][j][e] = 0.f;
}

template <class F>
DI void for_quads(f32x16 (&acc)[2][2], F f) {
  const int lane = get_tid() & 63, w = get_tid() >> 6, wm = w >> 1, wn = w & 1, r = lane & 31, h = lane >> 5;
#pragma unroll
  for (int i = 0; i < 2; ++i)
#pragma unroll
    for (int j = 0; j < 2; ++j)
#pragma unroll
      for (int g = 0; g < 4; ++g) {
        float v0 = acc[i][j][4 * g], v1 = acc[i][j][4 * g + 1], v2 = acc[i][j][4 * g + 2], v3 = acc[i][j][4 * g + 3];
        f(64 * wm + 32 * i + r, 64 * wn + 32 * j + 8 * g + 4 * h, i, v0, v1, v2, v3);
        acc[i][j][4 * g] = v0; acc[i][j][4 * g + 1] = v1; acc[i][j][4 * g + 2] = v2; acc[i][j][4 * g + 3] = v3;
      }
}

DI void transpose_tile(const float* __restrict__ src, int ldsrc, int srccol0, bf16_t* __restrict__ dst, int lddst, int dstrow0, int k0, float* smf) {
  const int tid = get_tid();
  __syncthreads();
#pragma unroll 4
  for (int i = 0; i < 16; ++i) { const int k = i * 4 + (tid >> 6), n = tid & 63; smf[k * 65 + n] = src[(size_t)(k0 + k) * ldsrc + srccol0 + n]; }
  __syncthreads();
#pragma unroll 4
  for (int i = 0; i < 16; ++i) { const int n = i * 4 + (tid >> 6), k = tid & 63; dst[(size_t)(dstrow0 + n) * lddst + k0 + k] = f2bf(smf[k * 65 + n]); }
}

DI void phase0(const Params& p, float* smf) {
  const int tid = get_tid();
  unsigned char* ws = p.ws;
  const int NT_IN = 16 * 224, NT_PM = 32 * 16, NT_PA = 16 * 16, NT_OUT = 16 * 16, PER_L = NT_IN + NT_PM + NT_PA + NT_OUT;
  const int N_TR = 2 * PER_L, N_MOD = 192, N_WG = 2;
  for (int it = blockIdx.x; it < N_TR + N_MOD + N_WG; it += gridDim.x) {
    if (it < N_TR) {
      const int l = it / PER_L;
      int q = it % PER_L;
      if (q < NT_IN) {
        const int nt = q / 16, kt = q % 16, n0 = nt * 64, sc = n0 < 8192 ? n0 : n0 + 8;
        transpose_tile(p.w_in + (size_t)l * 1024 * NIN, NIN, sc, (bf16_t*)(ws + OFF_WTIN) + (size_t)l * NPK * 1024, 1024, n0, kt * 64, smf);
      } else if ((q -= NT_IN) < NT_PM) {
        const int nt = q / 32, kt = q % 32;
        transpose_tile(p.w_proj_m + (size_t)l * 2048 * 1024, 1024, nt * 64, (bf16_t*)(ws + OFF_WTPM) + (size_t)l * 1024 * 2048, 2048, nt * 64, kt * 64, smf);
      } else if ((q -= NT_PM) < NT_PA) {
        const int nt = q / 16, kt = q % 16;
        transpose_tile(p.w_proj_a + (size_t)l * 1024 * 1024, 1024, nt * 64, (bf16_t*)(ws + OFF_WTPA) + (size_t)l * 1024 * 1024, 1024, nt * 64, kt * 64, smf);
      } else {
        q -= NT_PA;
        const int nt = q / 16, kt = q % 16;
        transpose_tile(p.w_out + (size_t)l * 1024 * 1024, 1024, nt * 64, (bf16_t*)(ws + OFF_WTOUT) + (size_t)l * 1024 * 1024, 1024, nt * 64, kt * 64, smf);
      }
    } else if (it < N_TR + N_MOD) {
      const int q = it - N_TR, l = q / 96, ch = q % 96;
      float* cact = smf;
      float* part = smf + 8192;
      __syncthreads();
      for (int i = tid; i < 8192; i += 256) cact[i] = siluf_(p.c[i]);
      __syncthreads();
      const int col = ch * 32 + (tid & 31), kg = tid >> 5;
      float a[8];
#pragma unroll
      for (int b = 0; b < 8; ++b) a[b] = 0.f;
      const float* wp = p.w_ada + (size_t)l * 1024 * 3072 + col;
      for (int k = kg * 128; k < kg * 128 + 128; ++k) {
        const float wv = wp[(size_t)k * 3072];
#pragma unroll
        for (int b = 0; b < 8; ++b) a[b] += cact[b * 1024 + k] * wv;
      }
#pragma unroll
      for (int b = 0; b < 8; ++b) part[(kg * 8 + b) * 32 + (tid & 31)] = a[b];
      __syncthreads();
      {
        const int b = tid >> 5, cc = tid & 31;
        float s = 0.f;
#pragma unroll
        for (int g = 0; g < 8; ++g) s += part[(g * 8 + b) * 32 + cc];
        const int colo = ch * 32 + cc;
        ((float*)(ws + OFF_MOD))[(l * 8 + b) * 3072 + colo] = s + p.b_ada[l * 3072 + colo];
      }
    } else {
      const int l = it - N_TR - N_MOD;
      float* wg = (float*)(ws + OFF_WG) + l * 8192;
      for (int i = tid; i < 8192; i += 256) wg[i] = p.w_in[(size_t)l * 1024 * NIN + (size_t)(i >> 3) * NIN + 8192 + (i & 7)];
    }
  }
}

DI void norm_rows(const Params& p, int l, int grp, int item_begin, int item_stride) {
  const int tid = get_tid(), lane = tid & 63, w = tid >> 6;
  unsigned char* ws = p.ws;
  const float* xin = (l == 0) ? p.x : p.out;
  const float* mod = (const float*)(ws + OFF_MOD);
  const float* wg = (const float*)(ws + OFF_WG) + l * 8192;
  bf16_t* H = (bf16_t*)(ws + OFF_H);
  float* GI = (float*)(ws + OFF_GI);
  float* GF = (float*)(ws + OFF_GF);
  for (int it = item_begin; it < TOK / 4; it += item_stride) {
    const int tl = it * 4 + w, bl = tl >> 12, t = tl & 4095, bg = grp * 2 + bl;
    const float* xr = xin + ((size_t)grp * TOK + tl) * DM;
    f32x4 xv[4];
    float ss = 0.f;
#pragma unroll
    for (int i = 0; i < 4; ++i) { xv[i] = *(const f32x4*)(xr + 256 * i + 4 * lane); ss += xv[i][0] * xv[i][0] + xv[i][1] * xv[i][1] + xv[i][2] * xv[i][2] + xv[i][3] * xv[i][3]; }
    ss = wave_sum(ss);
    const float rstd = rsqrtf(ss * (1.0f / DM) + EPS);
    float ga[8];
#pragma unroll
    for (int j = 0; j < 8; ++j) ga[j] = 0.f;
    const float* mrow = mod + (l * 8 + bg) * 3072;
#pragma unroll
    for (int i = 0; i < 4; ++i) {
      const int col = 256 * i + 4 * lane;
      const f32x4 g = *(const f32x4*)(p.norm_g + l * DM + col), sh = *(const f32x4*)(mrow + col), sc = *(const f32x4*)(mrow + 1024 + col);
      float hv[4];
#pragma unroll
      for (int e = 0; e < 4; ++e) hv[e] = xv[i][e] * rstd * g[e] * (1.0f + sc[e]) + sh[e];
      u32x2 o; o[0] = pack2(hv[0], hv[1]); o[1] = pack2(hv[2], hv[3]);
      *(u32x2*)(H + (size_t)tl * DM + col) = o;
#pragma unroll
      for (int e = 0; e < 4; ++e) {
        const f32x4 w0 = *(const f32x4*)(wg + (col + e) * 8), w1 = *(const f32x4*)(wg + (col + e) * 8 + 4);
#pragma unroll
        for (int j = 0; j < 4; ++j) { ga[j] += hv[e] * w0[j]; ga[4 + j] += hv[e] * w1[j]; }
      }
    }
#pragma unroll
    for (int j = 0; j < 8; ++j) ga[j] = wave_sum(ga[j]);
    if (lane < 8) {
      float v = ga[0];
#pragma unroll
      for (int j = 1; j < 8; ++j) v = (lane == j) ? ga[j] : v;
      v += p.b_if[l * 8 + lane];
      const int hh = lane & 3;
      float* dst = (lane < 4) ? GI : GF;
      dst[(bl * 4 + hh) * 4096 + t] = v;
    }
  }
}

DI void gate_scan(const Params& p, int bh, float* sf) {
  const int tid = get_tid(), g = tid >> 3, j = tid & 7, t0 = tid * 16;
  unsigned char* ws = p.ws;
  const float* GI = (const float*)(ws + OFF_GI) + bh * 4096 + t0;
  const float* GF = (const float*)(ws + OFF_GF) + bh * 4096 + t0;
  float* s_cm = sf; float* s_bl = sf + 32; float* s_mp = sf + 64; float* s_mml = sf + 96;
  float a[16], b[16], cm[16];
#pragma unroll
  for (int q = 0; q < 4; ++q) {
    const f32x4 fv = *(const f32x4*)(GF + 4 * q), iv = *(const f32x4*)(GI + 4 * q);
#pragma unroll
    for (int e = 0; e < 4; ++e) { const float f = fv[e]; b[4 * q + e] = fminf(f, 0.f) - log1pf(__expf(-fabsf(f))); a[4 * q + e] = iv[e]; }
  }
  float s = 0.f;
#pragma unroll
  for (int k = 0; k < 16; ++k) { s += b[k]; b[k] = s; }
  float inc = s;
#pragma unroll
  for (int o = 1; o < 8; o <<= 1) { const float v = __shfl_up(inc, o, 8); if (j >= o) inc += v; }
  const float excl = inc - s;
  float m = -INFINITY;
#pragma unroll
  for (int k = 0; k < 16; ++k) { b[k] += excl; a[k] -= b[k]; m = fmaxf(m, a[k]); cm[k] = m; }
  float inc2 = m;
#pragma unroll
  for (int o = 1; o < 8; o <<= 1) { const float v = __shfl_up(inc2, o, 8); if (j >= o) inc2 = fmaxf(inc2, v); }
  float exm = __shfl_up(inc2, 1, 8);
  if (j == 0) exm = -INFINITY;
#pragma unroll
  for (int k = 0; k < 16; ++k) cm[k] = fmaxf(cm[k], exm);
  __syncthreads();
  if (j == 7) { s_cm[g] = cm[15]; s_bl[g] = b[15]; }
  __syncthreads();
  if (tid == 0) {
    float mp = 0.f;
    float* GDEC = (float*)(ws + OFF_GDEC) + bh * 32;
    for (int c = 0; c < 32; ++c) {
      s_mp[c] = mp;
      const float mml = fmaxf(mp, s_cm[c]);
      s_mml[c] = mml;
      GDEC[c] = __expf(mp - mml);
      mp = s_bl[c] + mml;
    }
  }
  __syncthreads();
  const float mp = s_mp[g], mml = s_mml[g];
  float* GA = (float*)(ws + OFF_GA) + bh * 4096 + t0;
  float* GMM = (float*)(ws + OFF_GMM) + bh * 4096 + t0;
  float* GWI = (float*)(ws + OFF_GWI) + bh * 4096 + t0;
  float* GEM = (float*)(ws + OFF_GEM) + bh * 4096 + t0;
  float* GWK = (float*)(ws + OFF_GWK) + bh * 4096 + t0;
#pragma unroll
  for (int q = 0; q < 4; ++q) {
    f32x4 va, vmm, vwi, vem, vwk;
#pragma unroll
    for (int e = 0; e < 4; ++e) {
      const int k = 4 * q + e;
      const float mm = fmaxf(mp, cm[k]);
      va[e] = a[k]; vmm[e] = mm; vwi[e] = __expf(mp - mm); vem[e] = __expf(-(b[k] + mm)); vwk[e] = __expf(a[k] - mml);
    }
    *(f32x4*)(GA + 4 * q) = va; *(f32x4*)(GMM + 4 * q) = vmm; *(f32x4*)(GWI + 4 * q) = vwi; *(f32x4*)(GEM + 4 * q) = vem; *(f32x4*)(GWK + 4 * q) = vwk;
  }
}

DI void inproj_tile(const Params& p, int l, int mt, int nt, bf16_t* sm) {
  unsigned char* ws = p.ws;
  const bf16_t* H = (const bf16_t*)(ws + OFF_H) + (size_t)mt * 128 * DM;
  const bf16_t* W = (const bf16_t*)(ws + OFF_WTIN) + ((size_t)l * NPK + (size_t)nt * 128) * 1024;
  const int n0 = nt * 128;
  bool tr = false; int dcol = 0; bf16_t* tb = nullptr;
  if (n0 < 2048) dcol = n0;
  else if (n0 < 4096) { tr = true; tb = (bf16_t*)(ws + OFF_VMT) + ((size_t)((mt >> 5) * 2048 + (n0 - 2048))) * 4096 + (mt & 31) * 128; }
  else if (n0 < 10240) dcol = n0 - 2048;
  else if (n0 < 11264) { tr = true; tb = (bf16_t*)(ws + OFF_VAT) + ((size_t)((mt >> 5) * 1024 + (n0 - 10240))) * 4096 + (mt & 31) * 128; }
  else dcol = n0 - 3072;
  f32x16 acc[2][2];
  acc_zero(acc);
  if (!tr) {
    gemm_core<false, true>(H, DM, W, 1024, 1024, acc, sm, nullptr, 0);
    bf16_t* dst = (bf16_t*)(ws + OFF_NAT) + (size_t)mt * 128 * NATW + dcol;
    {
      const int lane_ = get_tid() & 63, w_ = get_tid() >> 6, wm_ = w_ >> 1, wn_ = w_ & 1, r_ = lane_ & 31, h_ = lane_ >> 5;
#pragma unroll
      for (int i = 0; i < 2; ++i)
#pragma unroll
        for (int j = 0; j < 2; ++j)
#pragma unroll
          for (int gp = 0; gp < 2; ++gp) {
            const int g0 = 2 * gp, g1 = 2 * gp + 1;
            const unsigned a0 = pack2(acc[i][j][4 * g0], acc[i][j][4 * g0 + 1]), a1 = pack2(acc[i][j][4 * g0 + 2], acc[i][j][4 * g0 + 3]);
            const unsigned b0 = pack2(acc[i][j][4 * g1], acc[i][j][4 * g1 + 1]), b1 = pack2(acc[i][j][4 * g1 + 2], acc[i][j][4 * g1 + 3]);
            auto ra = __builtin_amdgcn_permlane32_swap(a0, b0, false, false);
            auto rb = __builtin_amdgcn_permlane32_swap(a1, b1, false, false);
            u32x4 o; o[0] = ra[0]; o[1] = rb[0]; o[2] = ra[1]; o[3] = rb[1];
            *(u32x4*)(dst + (size_t)(64 * wm_ + 32 * i + r_) * NATW + 64 * wn_ + 32 * j + 8 * (2 * gp + h_)) = o;
          }
    }
  } else {
    gemm_core<false, true>(W, 1024, H, DM, 1024, acc, sm, nullptr, 0);
    for_quads(acc, [&](int ar, int br, int ii, float v0, float v1, float v2, float v3) {
      u32x2 o; o[0] = pack2(v0, v1); o[1] = pack2(v2, v3);
      *(u32x2*)(tb + (size_t)ar * 4096 + br) = o;
    });
  }
}

DI void conv_item(const Params& p, int l, int idx, float* smf) {
  const int tid = get_tid(), cg = tid & 31, tg = tid >> 5;
  unsigned char* ws = p.ws;
  const int which = idx & 1, c = (idx >> 1) & 31, bh = idx >> 6, bl = bh >> 2, h = bh & 3;
  const int ch0 = which * 1024 + h * 256 + 8 * cg;
  float w[4][8], bias[8];
#pragma unroll
  for (int j = 0; j < 4; ++j) {
    const f32x4 a0 = *(const f32x4*)(p.conv_w + (l * 4 + j) * 2048 + ch0), a1 = *(const f32x4*)(p.conv_w + (l * 4 + j) * 2048 + ch0 + 4);
#pragma unroll
    for (int e = 0; e < 4; ++e) { w[j][e] = a0[e]; w[j][4 + e] = a1[e]; }
  }
  {
    const f32x4 a0 = *(const f32x4*)(p.conv_b + l * 2048 + ch0), a1 = *(const f32x4*)(p.conv_b + l * 2048 + ch0 + 4);
#pragma unroll
    for (int e = 0; e < 4; ++e) { bias[e] = a0[e]; bias[4 + e] = a1[e]; }
  }
  const int ts = c * 128 + 16 * tg;
  const bf16_t* src = (const bf16_t*)(ws + OFF_NAT) + (size_t)bl * 4096 * NATW + (which ? C_KM : C_QM) + h * 256 + 8 * cg;
  u32x4 raw[19];
#pragma unroll
  for (int i = 0; i < 19; ++i) {
    const int t = ts - 3 + i;
    if (t >= 0) raw[i] = *(const u32x4*)(src + (size_t)t * NATW);
    else raw[i] = (u32x4){0u, 0u, 0u, 0u};
  }
  bf16_t* OUT = (bf16_t*)(ws + (which ? OFF_KN : OFF_Q)) + (size_t)bl * 4096 * 1024 + h * 256 + 8 * cg;
  bf16_t* KT = (bf16_t*)(ws + OFF_KT) + (size_t)(bh * 256 + 8 * cg) * 4096 + ts;
  const float* GWK = (const float*)(ws + OFF_GWK) + bh * 4096 + ts;
  float nacc[8];
#pragma unroll
  for (int e = 0; e < 8; ++e) nacc[e] = 0.f;
  const float osc = which ? 0.0625f : 1.0f;
#pragma unroll
  for (int half = 0; half < 2; ++half) {
    float ks[8][8];
    f32x4 wk0, wk1;
    if (which) { wk0 = *(const f32x4*)(GWK + 8 * half); wk1 = *(const f32x4*)(GWK + 8 * half + 4); }
#pragma unroll
    for (int tt = 0; tt < 8; ++tt) {
      const int i = 8 * half + tt;
      float y[8];
#pragma unroll
      for (int q = 0; q < 4; ++q) {
        const unsigned r0 = raw[i][q], r1 = raw[i + 1][q], r2 = raw[i + 2][q], r3 = raw[i + 3][q];
        y[2 * q] = w[3][2 * q] * bflo(r3) + bias[2 * q] + w[0][2 * q] * bflo(r0) + w[1][2 * q] * bflo(r1) + w[2][2 * q] * bflo(r2);
        y[2 * q + 1] = w[3][2 * q + 1] * bfhi(r3) + bias[2 * q + 1] + w[0][2 * q + 1] * bfhi(r0) + w[1][2 * q + 1] * bfhi(r1) + w[2][2 * q + 1] * bfhi(r2);
      }
#pragma unroll
      for (int e = 0; e < 8; ++e) y[e] = siluf_(y[e]) * osc;
      u32x4 o; o[0] = pack2(y[0], y[1]); o[1] = pack2(y[2], y[3]); o[2] = pack2(y[4], y[5]); o[3] = pack2(y[6], y[7]);
      *(u32x4*)(OUT + (size_t)(ts + i) * 1024) = o;
      if (which) {
        const float wkv = tt < 4 ? wk0[tt & 3] : wk1[tt & 3];
#pragma unroll
        for (int e = 0; e < 8; ++e) { ks[tt][e] = y[e] * wkv; nacc[e] += ks[tt][e]; }
      }
    }
    if (which) {
#pragma unroll
      for (int e = 0; e < 8; ++e) {
        u32x4 o; o[0] = pack2(ks[0][e], ks[1][e]); o[1] = pack2(ks[2][e], ks[3][e]); o[2] = pack2(ks[4][e], ks[5][e]); o[3] = pack2(ks[6][e], ks[7][e]);
        *(u32x4*)(KT + (size_t)e * 4096 + 8 * half) = o;
      }
    }
  }
  if (which) {
    __syncthreads();
#pragma unroll
    for (int e = 0; e < 8; ++e) smf[tg * 256 + 8 * cg + e] = nacc[e];
    __syncthreads();
    float s = 0.f;
#pragma unroll
    for (int g = 0; g < 8; ++g) s += smf[g * 256 + tid];
    ((float*)(ws + OFF_NLOC))[(bh * 32 + c) * 256 + tid] = s;
  }
}

DI void state_chain(const Params& p, int idx, int rd, bf16_t* sm) {
  unsigned char* ws = p.ws;
  const int bh = idx >> 3, i2 = (idx >> 2) & 1, j4 = idx & 3, bl = bh >> 2, h = bh & 3;
  const bf16_t* VT = (const bf16_t*)(ws + OFF_VMT) + (size_t)(bl * 2048 + h * 512 + j4 * 128) * 4096;
  const bf16_t* KT = (const bf16_t*)(ws + OFF_KT) + (size_t)(bh * 256 + i2 * 128) * 4096;
  const float* GDEC = (const float*)(ws + OFF_GDEC) + bh * 32;
  bf16_t* dst0 = (bf16_t*)(ws + OFF_CST) + ((size_t)(bh * 32) * 512 + j4 * 128) * 256 + i2 * 128;
  f32x16 acc[2][2];
  acc_zero(acc);
  auto snap = [&](int c) {
    bf16_t* dst = dst0 + (size_t)c * 512 * 256;
    for_quads(acc, [&](int ar, int br, int ii, float v0, float v1, float v2, float v3) {
      u32x2 o; o[0] = pack2(v0, v1); o[1] = pack2(v2, v3);
      *(u32x2*)(dst + (size_t)ar * 256 + br) = o;
    });
  };
  gemm_core<false, true>(VT, 4096, KT, 4096, 31 * 128, acc, sm, nullptr, 0, [&](int kt) {
    if ((kt & 1) == 0) {
      const int c = kt >> 1;
      snap(c);
      const float dec = GDEC[c];
#pragma unroll
      for (int i = 0; i < 2; ++i)
#pragma unroll
        for (int j = 0; j < 2; ++j) acc[i][j] *= dec;
    }
  });
  snap(31);
  asm volatile("s_waitcnt vmcnt(0)" ::: "memory");
  __syncthreads();
  if (get_tid() == 0) {
    __builtin_amdgcn_fence(__ATOMIC_RELEASE, "agent");
    asm volatile("s_waitcnt vmcnt(0)" ::: "memory");
    __hip_atomic_fetch_add((unsigned*)(ws + OFF_CNT) + 256 + rd * 8 + bh, 1u, __ATOMIC_RELAXED, __HIP_MEMORY_SCOPE_AGENT);
  }
}

constexpr int LDP = 136;
DI void mlstm_out_item(const Params& p, int l, int idx, int rd, bf16_t* sm) {
  const int tid = get_tid(), lane = tid & 63, h5 = lane >> 5;
  unsigned char* ws = p.ws;
  const int bh = idx >> 5, c = idx & 31, bl = bh >> 2, h = bh & 3;
  const size_t tok0 = (size_t)bl * 4096 + c * 128;
  bf16_t* Ps = sm + CORE_SM;
  float* vec = (float*)(sm + CORE_SM + 128 * LDP);
  float *sa = vec, *smm = vec + 128, *swi = vec + 256, *sden = vec + 384, *ssq = vec + 512, *sn = vec + 640, *sgem = vec + 896;
  const bf16_t* Q = (const bf16_t*)(ws + OFF_Q) + tok0 * 1024 + h * 256;
  const bf16_t* KN = (const bf16_t*)(ws + OFF_KN) + tok0 * 1024 + h * 256;
  const float* GDEC = (const float*)(ws + OFF_GDEC) + bh * 32;
  const float* GEM = (const float*)(ws + OFF_GEM) + bh * 4096 + c * 128;
  if (tid == 0) {
    unsigned* dn = (unsigned*)(ws + OFF_CNT) + 256 + rd * 8 + bh;
    unsigned sp = 0;
    while (__hip_atomic_load(dn, __ATOMIC_RELAXED, __HIP_MEMORY_SCOPE_AGENT) < 8u) { __builtin_amdgcn_s_sleep(8); if (++sp > (1u << 22)) break; }
    __builtin_amdgcn_fence(__ATOMIC_ACQUIRE, "agent");
    asm volatile("s_waitcnt vmcnt(0)" ::: "memory");
  }
  __syncthreads();
  if (tid < 128) {
    sa[tid] = ((const float*)(ws + OFF_GA))[bh * 4096 + c * 128 + tid];
    smm[tid] = ((const float*)(ws + OFF_GMM))[bh * 4096 + c * 128 + tid];
    swi[tid] = ((const float*)(ws + OFF_GWI))[bh * 4096 + c * 128 + tid];
    sden[tid] = 0.f;
    ssq[tid] = 0.f;
    sgem[tid] = GEM[tid];
  }
  {
    float n = 0.f;
    const float* NL = (const float*)(ws + OFF_NLOC) + (size_t)bh * 32 * 256 + tid;
#pragma unroll 1
    for (int c0 = 0; c0 < c; c0 += 8) {
      float nv[8], dv[8];
#pragma unroll
      for (int q = 0; q < 8; ++q) { const int cc = c0 + q < c ? c0 + q : c - 1; nv[q] = NL[cc * 256]; dv[q] = GDEC[cc]; }
#pragma unroll
      for (int q = 0; q < 8; ++q) if (c0 + q < c) n = n * dv[q] + nv[q];
    }
    sn[tid] = n;
  }
  __syncthreads();
  {
    const int t = tid >> 1, half = tid & 1;
    const bf16_t* qr = Q + (size_t)t * 1024 + half * 128;
    float d = 0.f;
#pragma unroll 4
    for (int k = 0; k < 128; k += 8) {
      const u32x4 v = *(const u32x4*)(qr + k);
      const float* nn = sn + half * 128 + k;
      d += bflo(v[0]) * nn[0] + bfhi(v[0]) * nn[1] + bflo(v[1]) * nn[2] + bfhi(v[1]) * nn[3] + bflo(v[2]) * nn[4] + bfhi(v[2]) * nn[5] + bflo(v[3]) * nn[6] + bfhi(v[3]) * nn[7];
    }
    atomicAdd(&sden[t], swi[t] * d);
  }
  f32x16 acc[2][2];
  acc_zero(acc);
  gemm_core<false, false>(Q, 1024, KN, 1024, 256, acc, sm, nullptr, 0);
  {
    float psum[2] = {0.f, 0.f};
    const int w = tid >> 6, wm = w >> 1, r = lane & 31;
    for_quads(acc, [&](int ar, int br, int ii, float v0, float v1, float v2, float v3) {
      const float mt = smm[ar];
      const f32x4 av = *(const f32x4*)(sa + br);
      const float p0 = (br + 0 <= ar) ? v0 * __expf(av[0] - mt) : 0.f;
      const float p1 = (br + 1 <= ar) ? v1 * __expf(av[1] - mt) : 0.f;
      const float p2 = (br + 2 <= ar) ? v2 * __expf(av[2] - mt) : 0.f;
      const float p3 = (br + 3 <= ar) ? v3 * __expf(av[3] - mt) : 0.f;
      psum[ii] += (p0 + p1) + (p2 + p3);
      u32x2 o; o[0] = pack2(p0, p1); o[1] = pack2(p2, p3);
      *(u32x2*)(Ps + ar * LDP + br) = o;
    });
#pragma unroll
    for (int i = 0; i < 2; ++i) {
      float s = psum[i];
      s += __shfl_xor(s, 32);
      if (h5 == 0) atomicAdd(&sden[64 * wm + 32 * i + r], s);
    }
  }
  __syncthreads();
  const bf16_t* OMp = (const bf16_t*)(ws + OFF_NAT) + tok0 * NATW + C_OM + h * 512;
  const bf16_t* ZMp = (const bf16_t*)(ws + OFF_NAT) + tok0 * NATW + C_ZM + h * 512;
  bf16_t* HMp = (bf16_t*)(ws + OFF_HM) + tok0 * 2048 + h * 512;
  bf16_t* Ht = sm;
  const int row = tid >> 1, hf = tid & 1;
  float sq = 0.f;
#pragma unroll 1
  for (int j4 = 0; j4 < 4; ++j4) {
    acc_zero(acc);
    if (c > 0) {
      gemm_core<false, false>(Q, 1024, (const bf16_t*)(ws + OFF_CST) + ((size_t)(bh * 32 + c) * 512 + j4 * 128) * 256, 256, 256, acc, sm, nullptr, 0);
      for_quads(acc, [&](int ar, int br, int ii, float& v0, float& v1, float& v2, float& v3) { const float s = swi[ar]; v0 *= s; v1 *= s; v2 *= s; v3 *= s; });
    }
    gemm_core<true, false>(nullptr, 0, (const bf16_t*)(ws + OFF_VMT) + (size_t)(bl * 2048 + h * 512 + j4 * 128) * 4096 + c * 128, 4096, 128, acc, sm, Ps, LDP);
    __syncthreads();
    for_quads(acc, [&](int ar, int br, int ii, float v0, float v1, float v2, float v3) {
      const float den = 1.0f / fmaxf(fabsf(sden[ar]), sgem[ar]);
      u32x2 o; o[0] = pack2(v0 * den, v1 * den); o[1] = pack2(v2 * den, v3 * den);
      *(u32x2*)(Ht + ar * LDP + br) = o;
    });
    __syncthreads();
#pragma unroll
    for (int q = 0; q < 8; ++q) {
      const int dv0 = hf * 64 + q * 8;
      const u32x4 hv = *(const u32x4*)(Ht + row * LDP + dv0);
      const u32x4 ov = *(const u32x4*)(OMp + (size_t)row * NATW + j4 * 128 + dv0);
      const u32x4 zv = *(const u32x4*)(ZMp + (size_t)row * NATW + j4 * 128 + dv0);
      const f32x4 g0 = *(const f32x4*)(p.mnorm_g + l * 2048 + h * 512 + j4 * 128 + dv0), g1 = *(const f32x4*)(p.mnorm_g + l * 2048 + h * 512 + j4 * 128 + dv0 + 4);
      u32x4 o;
#pragma unroll
      for (int e = 0; e < 4; ++e) {
        const float x0 = bflo(hv[e]) * sigmoidf_(bflo(ov[e])), x1 = bfhi(hv[e]) * sigmoidf_(bfhi(ov[e]));
        sq += x0 * x0 + x1 * x1;
        const float ga = e < 2 ? g0[2 * e] : g1[2 * e - 4], gb = e < 2 ? g0[2 * e + 1] : g1[2 * e - 3];
        o[e] = pack2(x0 * ga * siluf_(bflo(zv[e])), x1 * gb * siluf_(bfhi(zv[e])));
      }
      *(u32x4*)(HMp + (size_t)row * 2048 + j4 * 128 + dv0) = o;
    }
  }
  sq += __shfl_xor(sq, 1);
  if (hf == 0) ((float*)(ws + OFF_RS))[(tok0 + row) * 4 + h] = rsqrtf(sq * (1.0f / 512.0f) + EPS);
}

#define MFMA16(a, b, c) __builtin_amdgcn_mfma_f32_16x16x32_bf16((a), (b), (c), 0, 0, 0)
DI void attn_item(const Params& p, int l, int bl, int hd, int qb, bf16_t* sm) {
  const int tid = get_tid(), lane = tid & 63, w = tid >> 6, r16 = lane & 15, q4 = lane >> 4;
  unsigned char* ws = p.ws;
  bf16_t* Ks = sm;
  bf16_t* Vs = sm + 2 * 64 * LDT;
  float* tb = (float*)(sm + 2 * 64 * LDT + 128 * LDT);
  const bf16_t* NAT = (const bf16_t*)(ws + OFF_NAT) + (size_t)bl * 4096 * NATW;
  const bf16_t* VT = (const bf16_t*)(ws + OFF_VAT) + (size_t)(bl * 1024 + hd * 128) * 4096;
  const int wu = __builtin_amdgcn_readfirstlane(w);
  const int Q0 = qb * 64, t0 = Q0 + 16 * wu, t = t0 + r16;
  float lam;
  {
    float s1 = 0.f, s2 = 0.f;
    for (int i = 0; i < 64; ++i) { s1 += p.lam_q1[l * 64 + i] * p.lam_k1[l * 64 + i]; s2 += p.lam_q2[l * 64 + i] * p.lam_k2[l * 64 + i]; }
    lam = __expf(s1) - __expf(s2) + (l == 0 ? 0.2f : 0.35550906f);
  }
  const float oml = (l == 0) ? 0.8f : 0.64449094f;
  __syncthreads();
  if (tid < 129) {
    int bucket;
    if (tid < 16) bucket = tid;
    else { const float v = logf((float)tid / 16.0f) / 2.0794415416798357f * 16.0f; bucket = 16 + (int)v; if (bucket > 31) bucket = 31; }
    tb[tid] = p.rel_bias[bucket * 8 + hd] * LOG2E;
  }
  bf16_t* Qs = sm + 2 * 64 * LDT + 128 * LDT + 512;
#pragma unroll
  for (int pp = 0; pp < 4; ++pp) {
    const int id = tid + 256 * pp, row = id >> 4, ch = id & 15;
    *(u32x4*)(Qs + row * LDP + ch * 8) = *(const u32x4*)(NAT + (size_t)(Q0 + row) * NATW + C_QA + hd * 128 + ch * 8);
  }
  f32x4 O[2][8];
#pragma unroll
  for (int m = 0; m < 2; ++m)
#pragma unroll
    for (int jd = 0; jd < 8; ++jd)
#pragma unroll
      for (int e = 0; e < 4; ++e) O[m][jd][e] = 0.f;
  float Mx[2] = {-INFINITY, -INFINITY}, Ls[2] = {0.f, 0.f};
  const int ntile = qb + 1;
  const float c1 = 0.125f * LOG2E;
  u32x4 rk[4], rv[4];
#pragma unroll
  for (int pp = 0; pp < 4; ++pp) {
    const int id = tid + 256 * pp;
    rk[pp] = *(const u32x4*)(NAT + (size_t)((id >> 3) & 63) * NATW + C_KA + hd * 128 + (id >> 9) * 64 + (id & 7) * 8);
    rv[pp] = *(const u32x4*)(VT + (size_t)(id >> 3) * 4096 + (id & 7) * 8);
  }
#pragma unroll 1
  for (int kt = 0; kt < ntile; ++kt) {
    const int s0 = kt * 64;
    __syncthreads();
#pragma unroll
    for (int pp = 0; pp < 4; ++pp) {
      const int id = tid + 256 * pp;
      *(u32x4*)(Ks + ((id >> 9) * 64 + ((id >> 3) & 63)) * LDT + (id & 7) * 8) = rk[pp];
      *(u32x4*)(Vs + (id >> 3) * LDT + (id & 7) * 8) = rv[pp];
    }
    __syncthreads();
    if (kt + 1 < ntile) {
#pragma unroll
      for (int pp = 0; pp < 4; ++pp) {
        const int id = tid + 256 * pp;
        rk[pp] = *(const u32x4*)(NAT + (size_t)(s0 + 64 + ((id >> 3) & 63)) * NATW + C_KA + hd * 128 + (id >> 9) * 64 + (id & 7) * 8);
        rv[pp] = *(const u32x4*)(VT + (size_t)(id >> 3) * 4096 + s0 + 64 + (id & 7) * 8);
      }
    }
    if (s0 <= t0 + 15) {
      const bool nearb = (s0 + 63 + 128 > t0);
      const float tb128 = tb[128];
      u32x4 pk[2][2];
#pragma unroll
      for (int m = 0; m < 2; ++m) {
        f32x4 sacc[4];
#pragma unroll
        for (int st = 0; st < 4; ++st) {
#pragma unroll
          for (int e = 0; e < 4; ++e) sacc[st][e] = 0.f;
#pragma unroll
          for (int kk = 0; kk < 2; ++kk) {
            const bf16x8 a = *(const bf16x8*)(Ks + (m * 64 + 16 * st + r16) * LDT + kk * 32 + 8 * q4);
            const bf16x8 qfr = *(const bf16x8*)(Qs + (16 * wu + r16) * LDP + m * 64 + kk * 32 + 8 * q4);
            sacc[st] = MFMA16(a, qfr, sacc[st]);
          }
        }
        float alpha, ps = 0.f;
        if (!nearb) {
          float mx = fmaxf(fmaxf(sacc[0][0], sacc[0][1]), fmaxf(sacc[0][2], sacc[0][3]));
#pragma unroll
          for (int st = 1; st < 4; ++st) mx = fmaxf(mx, fmaxf(fmaxf(sacc[st][0], sacc[st][1]), fmaxf(sacc[st][2], sacc[st][3])));
          float Mn = Mx[m];
          alpha = 1.0f;
          if (__builtin_amdgcn_ballot_w64(mx * c1 + tb128 - Mn > 8.0f) != 0ull) {
            mx = fmaxf(mx, __shfl_xor(mx, 16));
            mx = fmaxf(mx, __shfl_xor(mx, 32));
            Mn = fmaxf(Mn, mx * c1 + tb128); alpha = __builtin_amdgcn_exp2f(Mx[m] - Mn); Mx[m] = Mn;
          }
          const float off = tb128 - Mn;
#pragma unroll
          for (int st = 0; st < 4; ++st)
#pragma unroll
            for (int e = 0; e < 4; ++e) { const float pv = __builtin_amdgcn_exp2f(sacc[st][e] * c1 + off); sacc[st][e] = pv; ps += pv; }
        } else {
          float mx = -INFINITY;
#pragma unroll
          for (int st = 0; st < 4; ++st)
#pragma unroll
            for (int e = 0; e < 4; ++e) {
              const int s = s0 + 16 * st + 4 * q4 + e;
              const int rel = t - s;
              int ri = rel < 0 ? 0 : rel; ri = ri > 128 ? 128 : ri;
              float xv = sacc[st][e] * c1 + tb[ri];
              if (rel < 0) xv = -INFINITY;
              sacc[st][e] = xv;
              mx = fmaxf(mx, xv);
            }
          float Mn = Mx[m];
          alpha = 1.0f;
          if (__builtin_amdgcn_ballot_w64(mx - Mn > 8.0f) != 0ull) {
            mx = fmaxf(mx, __shfl_xor(mx, 16));
            mx = fmaxf(mx, __shfl_xor(mx, 32));
            Mn = fmaxf(Mn, mx); alpha = __builtin_amdgcn_exp2f(Mx[m] - Mn); Mx[m] = Mn;
          }
#pragma unroll
          for (int st = 0; st < 4; ++st)
#pragma unroll
            for (int e = 0; e < 4; ++e) { const float pv = __builtin_amdgcn_exp2f(sacc[st][e] - Mn); sacc[st][e] = pv; ps += pv; }
        }
        Ls[m] = Ls[m] * alpha + ps;
        if (__builtin_amdgcn_ballot_w64(alpha != 1.0f) != 0ull) {
#pragma unroll
          for (int jd = 0; jd < 8; ++jd) O[m][jd] *= alpha;
        }
#pragma unroll
        for (int u = 0; u < 2; ++u) {
          pk[m][u][0] = pack2(sacc[2 * u][0], sacc[2 * u][1]); pk[m][u][1] = pack2(sacc[2 * u][2], sacc[2 * u][3]);
          pk[m][u][2] = pack2(sacc[2 * u + 1][0], sacc[2 * u + 1][1]); pk[m][u][3] = pack2(sacc[2 * u + 1][2], sacc[2 * u + 1][3]);
        }
        __builtin_amdgcn_sched_barrier(0);
      }
#pragma unroll
      for (int u = 0; u < 2; ++u) {
        const bf16x8 pf0 = __builtin_bit_cast(bf16x8, pk[0][u]), pf1 = __builtin_bit_cast(bf16x8, pk[1][u]);
#pragma unroll
        for (int jd = 0; jd < 8; ++jd) {
          if ((jd & 3) == 0) asm volatile("" ::: "memory");
          const bf16_t* vp = Vs + (16 * jd + r16) * LDT + 32 * u + 4 * q4;
          const s16x4 lo = *(const s16x4*)vp, hi = *(const s16x4*)(vp + 16);
          const bf16x8 vf = __builtin_shufflevector(lo, hi, 0, 1, 2, 3, 4, 5, 6, 7);
          O[0][jd] = MFMA16(vf, pf0, O[0][jd]);
          O[1][jd] = MFMA16(vf, pf1, O[1][jd]);
        }
      }
    }
  }
  float L1 = Ls[0], L2 = Ls[1];
  L1 += __shfl_xor(L1, 16); L1 += __shfl_xor(L1, 32);
  L2 += __shfl_xor(L2, 16); L2 += __shfl_xor(L2, 32);
  const float i1 = 1.0f / L1, i2 = lam / L2;
  float ss = 0.f;
#pragma unroll
  for (int jd = 0; jd < 8; ++jd)
#pragma unroll
    for (int e = 0; e < 4; ++e) { const float o = O[0][jd][e] * i1 - O[1][jd][e] * i2; O[0][jd][e] = o; ss += o * o; }
  ss += __shfl_xor(ss, 16); ss += __shfl_xor(ss, 32);
  const float rs = rsqrtf(ss * (1.0f / 128.0f) + EPS) * oml;
  const bf16_t* ZA = NAT + (size_t)t * NATW + C_ZA + hd * 128;
  bf16_t* HA = (bf16_t*)(ws + OFF_HA) + ((size_t)bl * 4096 + t) * 1024 + hd * 128;
  const float* ag = p.anorm_g + l * 1024 + hd * 128;
#pragma unroll
  for (int jd = 0; jd < 8; ++jd) {
    const int dv = 16 * jd + 4 * q4;
    const u32x2 zv = *(const u32x2*)(ZA + dv);
    const f32x4 gg = *(const f32x4*)(ag + dv);
    u32x2 o;
    o[0] = pack2(O[0][jd][0] * rs * gg[0] * siluf_(bflo(zv[0])), O[0][jd][1] * rs * gg[1] * siluf_(bfhi(zv[0])));
    o[1] = pack2(O[0][jd][2] * rs * gg[2] * siluf_(bflo(zv[1])), O[0][jd][3] * rs * gg[3] * siluf_(bfhi(zv[1])));
    *(u32x2*)(HA + dv) = o;
  }
}

DI void proj_tile(const Params& p, int l, int mt, int nt, bf16_t* sm) {
  unsigned char* ws = p.ws;
  f32x16 acc[2][2];
  acc_zero(acc);
  f32x4 rsv[2];
  {
    const int lane_ = get_tid() & 63, w_ = get_tid() >> 6;
#pragma unroll
    for (int i = 0; i < 2; ++i) rsv[i] = *(const f32x4*)((const float*)(ws + OFF_RS) + ((size_t)mt * 128 + 64 * (w_ >> 1) + 32 * i + (lane_ & 31)) * 4);
  }
  gemm_core<false, true>((const bf16_t*)(ws + OFF_HM) + (size_t)mt * 128 * 2048, 2048, (const bf16_t*)(ws + OFF_WTPM) + ((size_t)l * 1024 + nt * 128) * 2048, 2048, 2048, acc, sm, nullptr, 0, [&](int kt) {
    if (kt == 8) {
#pragma unroll
      for (int i = 0; i < 2; ++i) { const float f = rsv[i][0] / rsv[i][1]; acc[i][0] *= f; acc[i][1] *= f; }
    } else if (kt == 16) {
#pragma unroll
      for (int i = 0; i < 2; ++i) { const float f = rsv[i][1] / rsv[i][2]; acc[i][0] *= f; acc[i][1] *= f; }
    } else if (kt == 24) {
#pragma unroll
      for (int i = 0; i < 2; ++i) { const float f = rsv[i][2] / rsv[i][3]; acc[i][0] *= f; acc[i][1] *= f; }
    }
  });
#pragma unroll
  for (int i = 0; i < 2; ++i) { acc[i][0] *= rsv[i][3]; acc[i][1] *= rsv[i][3]; }
  const bf16_t* G = (const bf16_t*)(ws + OFF_NAT) + (size_t)mt * 128 * NATW + nt * 128;
  for_quads(acc, [&](int ar, int br, int ii, float& v0, float& v1, float& v2, float& v3) {
    const u32x2 gm = *(const u32x2*)(G + (size_t)ar * NATW + C_GM + br), ga = *(const u32x2*)(G + (size_t)ar * NATW + C_GA + br);
    v0 *= (1.0f + __expf(-bflo(ga[0]))) / (1.0f + __expf(-bflo(gm[0])));
    v1 *= (1.0f + __expf(-bfhi(ga[0]))) / (1.0f + __expf(-bfhi(gm[0])));
    v2 *= (1.0f + __expf(-bflo(ga[1]))) / (1.0f + __expf(-bflo(gm[1])));
    v3 *= (1.0f + __expf(-bfhi(ga[1]))) / (1.0f + __expf(-bfhi(gm[1])));
  });
  gemm_core<false, true>((const bf16_t*)(ws + OFF_HA) + (size_t)mt * 128 * 1024, 1024, (const bf16_t*)(ws + OFF_WTPA) + ((size_t)l * 1024 + nt * 128) * 1024, 1024, 1024, acc, sm, nullptr, 0);
  bf16_t* Y = (bf16_t*)(ws + OFF_Q) + (size_t)mt * 128 * 1024 + nt * 128;
  for_quads(acc, [&](int ar, int br, int ii, float v0, float v1, float v2, float v3) {
    const u32x2 ga = *(const u32x2*)(G + (size_t)ar * NATW + C_GA + br);
    u32x2 o;
    o[0] = pack2(v0 * sigmoidf_(bflo(ga[0])), v1 * sigmoidf_(bfhi(ga[0])));
    o[1] = pack2(v2 * sigmoidf_(bflo(ga[1])), v3 * sigmoidf_(bfhi(ga[1])));
    *(u32x2*)(Y + (size_t)ar * 1024 + br) = o;
  });
}

DI void out_tile(const Params& p, int l, int grp, int mt, int nt, bf16_t* sm) {
  unsigned char* ws = p.ws;
  f32x16 acc[2][2];
  acc_zero(acc);
  gemm_core<false, true>((const bf16_t*)(ws + OFF_Q) + (size_t)mt * 128 * 1024, 1024, (const bf16_t*)(ws + OFF_WTOUT) + ((size_t)l * 1024 + nt * 128) * 1024, 1024, 1024, acc, sm, nullptr, 0);
  const float* xin = ((l == 0) ? p.x : p.out) + ((size_t)grp * TOK + mt * 128) * DM + nt * 128;
  float* xo = p.out + ((size_t)grp * TOK + mt * 128) * DM + nt * 128;
  const float* gate = (const float*)(ws + OFF_MOD) + (l * 8 + grp * 2 + (mt >> 5)) * 3072 + 2048 + nt * 128;
  for_quads(acc, [&](int ar, int br, int ii, float v0, float v1, float v2, float v3) {
    const f32x4 xv = *(const f32x4*)(xin + (size_t)ar * DM + br);
    const f32x4 gv = *(const f32x4*)(gate + br);
    f32x4 o; o[0] = xv[0] + gv[0] * v0; o[1] = xv[1] + gv[1] * v1; o[2] = xv[2] + gv[2] * v2; o[3] = xv[3] + gv[3] * v3;
    *(f32x4*)(xo + (size_t)ar * DM + br) = o;
  });
}

DI void final_norm(const Params& p) {
  const int tid = get_tid(), lane = tid & 63, w = tid >> 6;
  for (int it = blockIdx.x; it < NBATCH * SEQ / 4; it += gridDim.x) {
    float* xr = p.out + ((size_t)it * 4 + w) * DM;
    f32x4 xv[4];
    float ss = 0.f;
#pragma unroll
    for (int i = 0; i < 4; ++i) { xv[i] = *(const f32x4*)(xr + 256 * i + 4 * lane); ss += xv[i][0] * xv[i][0] + xv[i][1] * xv[i][1] + xv[i][2] * xv[i][2] + xv[i][3] * xv[i][3]; }
    ss = wave_sum(ss);
    const float rstd = rsqrtf(ss * (1.0f / DM) + EPS);
#pragma unroll
    for (int i = 0; i < 4; ++i) {
      const f32x4 g = *(const f32x4*)(p.final_g + 256 * i + 4 * lane);
      f32x4 o; o[0] = xv[i][0] * rstd * g[0]; o[1] = xv[i][1] * rstd * g[1]; o[2] = xv[i][2] * rstd * g[2]; o[3] = xv[i][3] * rstd * g[3];
      *(f32x4*)(xr + 256 * i + 4 * lane) = o;
    }
  }
}


#define XB_TMO      128
#define XB_XCNT(j)  (256  + 64 * (j))
#define XB_XSUB(j)  (1280 + 64 * (j))
#define XB_XGEN(j)  (2304 + 64 * (j))
#define XB_TOP      3328
#define XB_TOPGEN   3392
#define XCD_BAR_WORDS 3456
#define XB_SPIN_CAP (1u << 22)
#define LAS __attribute__((address_space(3)))
DI unsigned xb_ld(unsigned* p) { return __hip_atomic_load(p, __ATOMIC_RELAXED, __HIP_MEMORY_SCOPE_AGENT); }
DI unsigned xb_add(unsigned* p, unsigned v) { return __hip_atomic_fetch_add(p, v, __ATOMIC_RELAXED, __HIP_MEMORY_SCOPE_AGENT); }
DI unsigned xb_xcc_id() { return (unsigned)__builtin_amdgcn_s_getreg((3 << 11) | 20) & 0xFu; }
#define XB_SPIN(cond, bar) do { unsigned _sp = 0; while (cond) { __builtin_amdgcn_s_sleep(1); \
    if ((++_sp & 255u) == 0u) { if (xb_ld(&(bar)[XB_TMO])) break; if (_sp > XB_SPIN_CAP) { atomicAdd(&(bar)[XB_TMO], 1u); break; } } } } while (0)
struct XcdBarrier { unsigned* bar; unsigned x; volatile LAS unsigned* st; };
DI XcdBarrier xcd_barrier_post(unsigned* bar, volatile LAS unsigned* st) {
  XcdBarrier b; b.bar = bar; b.x = xb_xcc_id(); b.st = st;
  if (threadIdx.x == 0) (void)xb_add(&bar[XB_XCNT(b.x)], 1u);
  return b;
}
DI void xcd_barrier_complete(unsigned* bar, unsigned x, unsigned& nloc, unsigned& nx) {
  const unsigned G = gridDim.x * gridDim.y * gridDim.z;
  unsigned sum, cnt, mine, sp = 0u;
  for (;;) {
    sum = 0u; cnt = 0u; mine = 0u;
#pragma unroll
    for (unsigned j = 0; j < 16; ++j) { const unsigned c = xb_ld(&bar[XB_XCNT(j)]); sum += c; cnt += (c > 0u) ? 1u : 0u; mine = (j == x) ? c : mine; }
    if (sum == G) break;
    __builtin_amdgcn_s_sleep(1);
    if ((++sp & 255u) == 0u) { if (xb_ld(&bar[XB_TMO])) break; if (sp > XB_SPIN_CAP) { atomicAdd(&bar[XB_TMO], 1u); break; } }
  }
  nloc = mine > 0u ? mine : 1u; nx = cnt > 0u ? cnt : 1u;
}
DI void xcd_barrier(const XcdBarrier& b) {
  asm volatile("s_waitcnt vmcnt(0)" ::: "memory");
  __syncthreads();
  if (threadIdx.x == 0) {
    unsigned* bar = b.bar;
    __builtin_amdgcn_s_waitcnt(0);
    unsigned nloc = b.st[0], nx = b.st[1];
    if (nloc == 0u) { xcd_barrier_complete(bar, b.x, nloc, nx); b.st[0] = nloc; b.st[1] = nx; }
    const unsigned old = xb_add(&bar[XB_XSUB(b.x)], 1u);
    const unsigned gen = old / nloc;
    if (old + 1u == (gen + 1u) * nloc) {
      __builtin_amdgcn_fence(__ATOMIC_RELEASE, "agent");
      asm volatile("s_waitcnt vmcnt(0)" ::: "memory");
      const unsigned og = xb_add(&bar[XB_TOP], 1u);
      const unsigned tg = og / nx;
      if (og + 1u == (tg + 1u) * nx) xb_add(&bar[XB_TOPGEN], 1u);
      else XB_SPIN(xb_ld(&bar[XB_TOPGEN]) == tg, bar);
      __builtin_amdgcn_fence(__ATOMIC_ACQUIRE, "agent");
      xb_add(&bar[XB_XGEN(b.x)], 1u);
      asm volatile("s_waitcnt vmcnt(0)" ::: "memory");
    } else {
      XB_SPIN(xb_ld(&bar[XB_XGEN(b.x)]) == gen, bar);
      __builtin_amdgcn_fence(__ATOMIC_ACQUIRE, "agent");
      asm volatile("s_waitcnt vmcnt(0)" ::: "memory");
    }
  }
  __syncthreads();
}

constexpr int SMEM_BYTES = (CORE_SM + 128 * LDP) * 2 + 1024 * 4;

__global__ void __launch_bounds__(256, 2) fwd_megakernel(Params p) {
  cg::grid_group grid = cg::this_grid();
#define GSYNC() xcd_barrier(xb)
  extern __shared__ __attribute__((aligned(16))) unsigned char smem_raw[];
  bf16_t* sm = (bf16_t*)smem_raw;
  __shared__ __attribute__((aligned(16))) unsigned s_static[8];
#define s_item (*(volatile int*)&s_static[4])
  const int tid = get_tid();
  int* cnt = (int*)(p.ws + OFF_CNT);
#ifdef PROBE_SEL_A
  float tacc[8] = {0.f, 0.f, 0.f, 0.f, 0.f, 0.f, 0.f, 0.f};
  unsigned long long tlast = wall_clock64();
#define TS(k) { const unsigned long long now_ = wall_clock64(); tacc[k] += (float)(now_ - tlast); tlast = now_; }
#elif defined(PROBE_AMP)
  unsigned long long tlast = wall_clock64();
#define TS(k) { if (blockIdx.x == 0) { const unsigned long long now_ = wall_clock64(); if ((k) == PROBE_AMP) { const unsigned long long dt_ = now_ - tlast; while (wall_clock64() - now_ < 4ull * dt_) __builtin_amdgcn_s_sleep(16); } tlast = wall_clock64(); } }
#else
#define TS(k)
#endif

  if (threadIdx.x < 8) s_static[threadIdx.x] = 0u;
  __syncthreads();
  XcdBarrier xb = xcd_barrier_post((unsigned*)(p.ws + OFF_BAR), (volatile LAS unsigned*)s_static);
  phase0(p, (float*)smem_raw);
#ifdef DBL_P0
  phase0(p, (float*)smem_raw);
#endif
  grid.sync();
  norm_rows(p, 0, 0, blockIdx.x, gridDim.x);
  GSYNC();
  TS(0)

  for (int rd = 0; rd < 8; ++rd) {
    const int l = rd >> 2;
    if (blockIdx.x < 8) gate_scan(p, blockIdx.x, (float*)smem_raw);
    if (rd > 0) for (int it = blockIdx.x; it < 512; it += gridDim.x) out_tile(p, (rd - 1) >> 2, (rd - 1) & 3, it & 63, it >> 6, sm);
#ifdef DBL_B
    for (int rep = 0; rep < 2; ++rep)
#endif
    for (int it = blockIdx.x; it < 64 * 112; it += gridDim.x) inproj_tile(p, l, it & 63, it >> 6, sm);
    GSYNC();
    TS(1)
#ifdef DBL_CONV
    for (int rep = 0; rep < 2; ++rep)
#endif
    for (int it = blockIdx.x; it < 512; it += gridDim.x) conv_item(p, l, it, (float*)smem_raw);
    if (rd < 7) norm_rows(p, (rd + 1) >> 2, (rd + 1) & 3, blockIdx.x, gridDim.x);
    GSYNC();
    TS(2)
#ifdef DBL_C1
    for (int rep = 0; rep < 2; ++rep)
#else
    const int rep = 0;
#endif
    for (;;) {
      const int rdx = rd + 8 * rep;
      __syncthreads();
      if (tid == 0) s_item = atomicAdd(&cnt[rdx * 16], 1);
      __syncthreads();
      const int it = s_item;
      if (it >= 64 + 1024 + 256) break;
      if (it < 64) state_chain(p, it, rdx, sm);
      else if (it < 448 || it >= 704) {
        int k, qb;
        if (it < 448) { k = it - 64; qb = 63 - (k >> 4); }
        else { k = it - 704; qb = 39 - (k >> 4); }
        attn_item(p, l, (k >> 3) & 1, k & 7, qb, sm);
      } else mlstm_out_item(p, l, it - 448, rdx, sm);
    }
    GSYNC();
    TS(4)
#ifdef DBL_PROJ
    for (int rep = 0; rep < 2; ++rep)
#endif
    for (int it = blockIdx.x; it < 512; it += gridDim.x) proj_tile(p, l, it & 63, it >> 6, sm);
    GSYNC();
    TS(5)
  }
  for (int it = blockIdx.x; it < 512; it += gridDim.x) out_tile(p, 1, 3, it & 63, it >> 6, sm);
  GSYNC();
  TS(6)
  final_norm(p);
#ifdef PROBE_SEL_A
  TS(7)
  __syncthreads();
  if (blockIdx.x == 0 && tid == 0) { p.out[0] += tacc[PROBE_SEL_A] * 0.01f; p.out[1] += tacc[PROBE_SEL_B] * 0.01f; }
#endif
}

extern "C" void kernel_launch(void* const* d_in, const int* in_sizes, int n_in, void* d_out, int out_size, void* d_ws, size_t ws_size, hipStream_t stream) {
  static int grid_blocks = 0;
  if (!grid_blocks) {
    int dev = 0, cus = 0, per_cu = 0;
    hipGetDevice(&dev);
    hipDeviceGetAttribute(&cus, hipDeviceAttributeMultiprocessorCount, dev);
    hipFuncSetAttribute((const void*)fwd_megakernel, hipFuncAttributeMaxDynamicSharedMemorySize, SMEM_BYTES);
    hipOccupancyMaxActiveBlocksPerMultiprocessor(&per_cu, (const void*)fwd_megakernel, 256, SMEM_BYTES);
    if (per_cu < 1) per_cu = 1;
    if (per_cu > 2) per_cu = 2;
    grid_blocks = cus * per_cu;
    if (ws_size < WS_END) fprintf(stderr, "kernel_launch: workspace too small: %zu < %zu\n", ws_size, (size_t)WS_END);
  }
  Params p{};
  const float** pp = (const float**)&p;
  for (int i = 0; i < 20; ++i) pp[i] = (const float*)d_in[i];
  p.out = (float*)d_out;
  p.ws = (unsigned char*)d_ws;
  hipMemsetAsync(d_ws, 0, 20480, stream);
  void* args[] = {&p};
  hipError_t e = hipLaunchCooperativeKernel((const void*)fwd_megakernel, dim3(grid_blocks), dim3(256), args, SMEM_BYTES, stream);
  if (e != hipSuccess) fprintf(stderr, "cooperative launch failed: %s (grid %d)\n", hipGetErrorString(e), grid_blocks);
}
```

```cpp
#include <hip/hip_runtime.h>
#define SGB 1
#include <hip/hip_cooperative_groups.h>
#include <cstdio>
#include <cstdint>
namespace cg = cooperative_groups;

typedef unsigned short bf16_t;
typedef short bf16x8 __attribute__((ext_vector_type(8)));
typedef short s16x4 __attribute__((ext_vector_type(4)));
typedef float f32x16 __attribute__((ext_vector_type(16)));
typedef float f32x4 __attribute__((ext_vector_type(4)));
typedef unsigned u32x4 __attribute__((ext_vector_type(4)));
typedef unsigned u32x2 __attribute__((ext_vector_type(2)));
#define DI __device__ __forceinline__
#define MFMA32(a, b, c) __builtin_amdgcn_mfma_f32_32x32x16_bf16((a), (b), (c), 0, 0, 0)

constexpr int DM = 1024, SEQ = 4096, NBATCH = 8, TOK = 8192  , NIN = 14344, NPK = 14336, NATW = 11264;
constexpr int C_QM = 0, C_KM = 1024, C_OM = 2048, C_ZM = 4096, C_QA = 6144, C_KA = 7168, C_ZA = 8192, C_GM = 9216, C_GA = 10240;
constexpr float EPS = 1e-6f, LOG2E = 1.4426950408889634f;

constexpr size_t al256(size_t x) { return (x + 255) & ~(size_t)255; }
constexpr size_t OFF_CNT = 0;
constexpr size_t OFF_BAR = 4096;
constexpr size_t OFF_MOD = 20480;
constexpr size_t OFF_WG = OFF_MOD + al256(2 * 8 * 3072 * 4);
constexpr size_t OFF_GI = OFF_WG + al256(2 * 1024 * 8 * 4);
constexpr size_t OFF_GF = OFF_GI + 131072;
constexpr size_t OFF_GA = OFF_GF + 131072;
constexpr size_t OFF_GMM = OFF_GA + 131072;
constexpr size_t OFF_GWI = OFF_GMM + 131072;
constexpr size_t OFF_GEM = OFF_GWI + 131072;
constexpr size_t OFF_GWK = OFF_GEM + 131072;
constexpr size_t OFF_GDEC = OFF_GWK + 131072;
constexpr size_t OFF_NLOC = OFF_GDEC + 1024;
constexpr size_t OFF_WTIN = OFF_NLOC + 262144;
constexpr size_t OFF_WTPM = OFF_WTIN + (size_t)2 * NPK * 1024 * 2;
constexpr size_t OFF_WTPA = OFF_WTPM + (size_t)2 * 1024 * 2048 * 2;
constexpr size_t OFF_WTOUT = OFF_WTPA + (size_t)2 * 1024 * 1024 * 2;
constexpr size_t OFF_H = OFF_WTOUT + (size_t)2 * 1024 * 1024 * 2;
constexpr size_t OFF_NAT = OFF_H + (size_t)TOK * 1024 * 2;
constexpr size_t OFF_VMT = OFF_NAT + (size_t)TOK * NATW * 2;
constexpr size_t OFF_VAT = OFF_VMT + (size_t)2 * 2048 * 4096 * 2;
constexpr size_t OFF_Q = OFF_VAT + (size_t)2 * 1024 * 4096 * 2;
constexpr size_t OFF_KN = OFF_Q + (size_t)TOK * 1024 * 2;
constexpr size_t OFF_KT = OFF_KN + (size_t)TOK * 1024 * 2;
constexpr size_t OFF_CST = OFF_KT + (size_t)TOK * 1024 * 2;
constexpr size_t OFF_HM = OFF_CST + (size_t)8 * 32 * 512 * 256 * 2;
constexpr size_t OFF_HA = OFF_HM + (size_t)TOK * 2048 * 2;
constexpr size_t OFF_RS = OFF_HA + (size_t)TOK * 1024 * 2;
constexpr size_t WS_END = OFF_RS + (size_t)TOK * 4 * 4;

struct Params {
  const float *x, *c, *norm_g, *w_ada, *b_ada, *w_in, *b_if, *conv_w, *conv_b, *mnorm_g, *w_proj_m, *lam_q1, *lam_k1, *lam_q2, *lam_k2, *anorm_g, *w_proj_a, *w_out, *rel_bias, *final_g;
  float* out;
  unsigned char* ws;
};

DI int get_tid() { int t = (int)__builtin_amdgcn_workitem_id_x(); asm volatile("" : "+v"(t)); return t; }
DI unsigned short f2bf(float x) { return __builtin_bit_cast(unsigned short, (__bf16)x); }
typedef __bf16 hbf2 __attribute__((ext_vector_type(2)));
typedef float f32x2 __attribute__((ext_vector_type(2)));
DI unsigned pack2(float a, float b) { f32x2 v = {a, b}; hbf2 r = __builtin_convertvector(v, hbf2); return __builtin_bit_cast(unsigned, r); }
DI float bflo(unsigned v) { return __uint_as_float(v << 16); }
DI float bfhi(unsigned v) { return __uint_as_float(v & 0xffff0000u); }
DI float sigmoidf_(float x) { return 1.0f / (1.0f + __expf(-x)); }
DI float siluf_(float x) { return x / (1.0f + __expf(-x)); }
DI float wave_sum(float v) {
#pragma unroll
  for (int o = 32; o > 0; o >>= 1) v += __shfl_xor(v, o);
  return v;
}

constexpr int LDT = 72;
constexpr int CORE_SM = 2 * 128 * LDT;
struct NoHook { DI void operator()(int) const {} };
template <bool A_LDS, bool DB, class Hook = NoHook>
DI void gemm_core(const bf16_t* __restrict__ A, int lda, const bf16_t* __restrict__ B, int ldb, int K, f32x16 (&acc)[2][2], bf16_t* sm,
                  const bf16_t* aL, int ldaL, Hook hook = Hook()) {
  const int tid = get_tid(), lane = tid & 63, w = tid >> 6, wm = w >> 1, wn = w & 1, r = lane & 31, h = lane >> 5;
  const int lr = tid >> 3, lc = (tid & 7) * 8;
  u32x4 ra[4], rb[4];
  const int nk = K >> 6;
#pragma unroll
  for (int p = 0; p < 4; ++p) {
    if (!A_LDS) ra[p] = *(const u32x4*)(A + (size_t)(lr + 32 * p) * lda + lc);
    rb[p] = *(const u32x4*)(B + (size_t)(lr + 32 * p) * ldb + lc);
  }
  if (DB) {
    __syncthreads();
#pragma unroll
    for (int p = 0; p < 4; ++p) {
      if (!A_LDS) *(u32x4*)(sm + (lr + 32 * p) * LDT + lc) = ra[p];
      *(u32x4*)(sm + 128 * LDT + (lr + 32 * p) * LDT + lc) = rb[p];
    }
    if (nk > 1) {
#pragma unroll
      for (int p = 0; p < 4; ++p) {
        if (!A_LDS) ra[p] = *(const u32x4*)(A + (size_t)(lr + 32 * p) * lda + 64 + lc);
        rb[p] = *(const u32x4*)(B + (size_t)(lr + 32 * p) * ldb + 64 + lc);
      }
    }
    __syncthreads();
  }
#pragma unroll 1
  for (int kt = 0; kt < nk; ++kt) {
    hook(kt);
    bf16_t* As;
    if (DB) {
      As = sm + (kt & 1) * CORE_SM;
      bf16_t* Nx = sm + ((kt + 1) & 1) * CORE_SM;
      if (kt + 1 < nk) {
#pragma unroll
        for (int p = 0; p < 4; ++p) {
          if (!A_LDS) *(u32x4*)(Nx + (lr + 32 * p) * LDT + lc) = ra[p];
          *(u32x4*)(Nx + 128 * LDT + (lr + 32 * p) * LDT + lc) = rb[p];
        }
      }
      if (kt + 2 < nk) {
        const int ko = (kt + 2) * 64 + lc;
#pragma unroll
        for (int p = 0; p < 4; ++p) {
          if (!A_LDS) ra[p] = *(const u32x4*)(A + (size_t)(lr + 32 * p) * lda + ko);
          rb[p] = *(const u32x4*)(B + (size_t)(lr + 32 * p) * ldb + ko);
        }
      }
    } else {
      As = sm;
      __syncthreads();
#pragma unroll
      for (int p = 0; p < 4; ++p) {
        if (!A_LDS) *(u32x4*)(As + (lr + 32 * p) * LDT + lc) = ra[p];
        *(u32x4*)(As + 128 * LDT + (lr + 32 * p) * LDT + lc) = rb[p];
      }
      __syncthreads();
      if (kt + 1 < nk) {
        const int ko = (kt + 1) * 64 + lc;
#pragma unroll
        for (int p = 0; p < 4; ++p) {
          if (!A_LDS) ra[p] = *(const u32x4*)(A + (size_t)(lr + 32 * p) * lda + ko);
          rb[p] = *(const u32x4*)(B + (size_t)(lr + 32 * p) * ldb + ko);
        }
      }
    }
    const bf16_t* Bs = As + 128 * LDT;
    __builtin_amdgcn_s_setprio(2);
#pragma unroll
    for (int kk = 0; kk < 4; ++kk) {
      bf16x8 af[2], bfr[2];
#pragma unroll
      for (int i = 0; i < 2; ++i) {
        if (A_LDS) af[i] = *(const bf16x8*)(aL + (64 * wm + 32 * i + r) * ldaL + kt * 64 + kk * 16 + 8 * h);
        else af[i] = *(const bf16x8*)(As + (64 * wm + 32 * i + r) * LDT + kk * 16 + 8 * h);
      }
#pragma unroll
      for (int j = 0; j < 2; ++j) bfr[j] = *(const bf16x8*)(Bs + (64 * wn + 32 * j + r) * LDT + kk * 16 + 8 * h);
#pragma unroll
      for (int i = 0; i < 2; ++i)
#pragma unroll
        for (int j = 0; j < 2; ++j) acc[i][j] = MFMA32(bfr[j], af[i], acc[i][j]);
    }
#ifdef SGB
    __builtin_amdgcn_sched_group_barrier(0x100, 4, 0);
#pragma unroll
    for (int q = 0; q < 12; ++q) { __builtin_amdgcn_sched_group_barrier(0x008, 1, 0); __builtin_amdgcn_sched_group_barrier(0x100, 1, 0); }
    __builtin_amdgcn_sched_group_barrier(0x008, 4, 0);
#endif
    __builtin_amdgcn_s_setprio(0);
    if (DB) __syncthreads();
  }
}

DI void acc_zero(f32x16 (&acc)[2][2]) {
#pragma unroll
  for (int i = 0; i < 2; ++i)
#pragma unroll
    for (int j = 0; j < 2; ++j)
#pragma unroll
      for (int e = 0; e < 16; ++e) acc[i][j][e] = 0.f;
}

template <class F>
DI void for_quads(f32x16 (&acc)[2][2], F f) {
  const int lane = get_tid() & 63, w = get_tid() >> 6, wm = w >> 1, wn = w & 1, r = lane & 31, h = lane >> 5;
#pragma unroll
  for (int i = 0; i < 2; ++i)
#pragma unroll
    for (int j = 0; j < 2; ++j)
#pragma unroll
      for (int g = 0; g < 4; ++g) {
        float v0 = acc[i][j][4 * g], v1 = acc[i][j][4 * g + 1], v2 = acc[i][j][4 * g + 2], v3 = acc[i][j][4 * g + 3];
        f(64 * wm + 32 * i + r, 64 * wn + 32 * j + 8 * g + 4 * h, i, v0, v1, v2, v3);
        acc[i][j][4 * g] = v0; acc[i][j][4 * g + 1] = v1; acc[i][j][4 * g + 2] = v2; acc[i][j][4 * g + 3] = v3;
      }
}

DI void store_acc_bf16x8(f32x16 (&acc)[2][2], bf16_t* dst, size_t ld) {
  const int lane_ = get_tid() & 63, w_ = get_tid() >> 6, wm_ = w_ >> 1, wn_ = w_ & 1, r_ = lane_ & 31, h_ = lane_ >> 5;
#pragma unroll
  for (int i = 0; i < 2; ++i)
#pragma unroll
    for (int j = 0; j < 2; ++j)
#pragma unroll
      for (int gp = 0; gp < 2; ++gp) {
        const int g0 = 2 * gp, g1 = 2 * gp + 1;
        const unsigned a0 = pack2(acc[i][j][4 * g0], acc[i][j][4 * g0 + 1]), a1 = pack2(acc[i][j][4 * g0 + 2], acc[i][j][4 * g0 + 3]);
        const unsigned b0 = pack2(acc[i][j][4 * g1], acc[i][j][4 * g1 + 1]), b1 = pack2(acc[i][j][4 * g1 + 2], acc[i][j][4 * g1 + 3]);
        auto ra = __builtin_amdgcn_permlane32_swap(a0, b0, false, false);
        auto rb = __builtin_amdgcn_permlane32_swap(a1, b1, false, false);
        u32x4 o; o[0] = ra[0]; o[1] = rb[0]; o[2] = ra[1]; o[3] = rb[1];
        *(u32x4*)(dst + (size_t)(64 * wm_ + 32 * i + r_) * ld + 64 * wn_ + 32 * j + 8 * (2 * gp + h_)) = o;
      }
}

DI void transpose_tile(const float* __restrict__ src, int ldsrc, int srccol0, bf16_t* __restrict__ dst, int lddst, int dstrow0, int k0, float* smf) {
  const int tid = get_tid();
  __syncthreads();
#pragma unroll 4
  for (int i = 0; i < 16; ++i) { const int k = i * 4 + (tid >> 6), n = tid & 63; smf[k * 65 + n] = src[(size_t)(k0 + k) * ldsrc + srccol0 + n]; }
  __syncthreads();
#pragma unroll 4
  for (int i = 0; i < 16; ++i) { const int n = i * 4 + (tid >> 6), k = tid & 63; dst[(size_t)(dstrow0 + n) * lddst + k0 + k] = f2bf(smf[k * 65 + n]); }
}

DI void phase0(const Params& p, float* smf) {
  const int tid = get_tid();
  unsigned char* ws = p.ws;
  const int NT_IN = 16 * 224, NT_PM = 32 * 16, NT_PA = 16 * 16, NT_OUT = 16 * 16, PER_L = NT_IN + NT_PM + NT_PA + NT_OUT;
  const int N_TR = 2 * PER_L, N_MOD = 192, N_WG = 2;
  for (int it = blockIdx.x; it < N_TR + N_MOD + N_WG; it += gridDim.x) {
    if (it < N_TR) {
      const int l = it / PER_L;
      int q = it % PER_L;
      if (q < NT_IN) {
        const int nt = q / 16, kt = q % 16, n0 = nt * 64, sc = n0 < 8192 ? n0 : n0 + 8;
        transpose_tile(p.w_in + (size_t)l * 1024 * NIN, NIN, sc, (bf16_t*)(ws + OFF_WTIN) + (size_t)l * NPK * 1024, 1024, n0, kt * 64, smf);
      } else if ((q -= NT_IN) < NT_PM) {
        const int nt = q / 32, kt = q % 32;
        transpose_tile(p.w_proj_m + (size_t)l * 2048 * 1024, 1024, nt * 64, (bf16_t*)(ws + OFF_WTPM) + (size_t)l * 1024 * 2048, 2048, nt * 64, kt * 64, smf);
      } else if ((q -= NT_PM) < NT_PA) {
        const int nt = q / 16, kt = q % 16;
        transpose_tile(p.w_proj_a + (size_t)l * 1024 * 1024, 1024, nt * 64, (bf16_t*)(ws + OFF_WTPA) + (size_t)l * 1024 * 1024, 1024, nt * 64, kt * 64, smf);
      } else {
        q -= NT_PA;
        const int nt = q / 16, kt = q % 16;
        transpose_tile(p.w_out + (size_t)l * 1024 * 1024, 1024, nt * 64, (bf16_t*)(ws + OFF_WTOUT) + (size_t)l * 1024 * 1024, 1024, nt * 64, kt * 64, smf);
      }
    } else if (it < N_TR + N_MOD) {
      const int q = it - N_TR, l = q / 96, ch = q % 96;
      float* cact = smf;
      float* part = smf + 8192;
      __syncthreads();
      for (int i = tid; i < 8192; i += 256) cact[i] = siluf_(p.c[i]);
      __syncthreads();
      const int col = ch * 32 + (tid & 31), kg = tid >> 5;
      float a[8];
#pragma unroll
      for (int b = 0; b < 8; ++b) a[b] = 0.f;
      const float* wp = p.w_ada + (size_t)l * 1024 * 3072 + col;
      for (int k = kg * 128; k < kg * 128 + 128; ++k) {
        const float wv = wp[(size_t)k * 3072];
#pragma unroll
        for (int b = 0; b < 8; ++b) a[b] += cact[b * 1024 + k] * wv;
      }
#pragma unroll
      for (int b = 0; b < 8; ++b) part[(kg * 8 + b) * 32 + (tid & 31)] = a[b];
      __syncthreads();
      {
        const int b = tid >> 5, cc = tid & 31;
        float s = 0.f;
#pragma unroll
        for (int g = 0; g < 8; ++g) s += part[(g * 8 + b) * 32 + cc];
        const int colo = ch * 32 + cc;
        ((float*)(ws + OFF_MOD))[(l * 8 + b) * 3072 + colo] = s + p.b_ada[l * 3072 + colo];
      }
    } else {
      const int l = it - N_TR - N_MOD;
      float* wg = (float*)(ws + OFF_WG) + l * 8192;
      for (int i = tid; i < 8192; i += 256) wg[i] = p.w_in[(size_t)l * 1024 * NIN + (size_t)(i >> 3) * NIN + 8192 + (i & 7)];
    }
  }
}

DI void norm_rows(const Params& p, int l, int grp, int item_begin, int item_stride) {
  const int tid = get_tid(), lane = tid & 63, w = tid >> 6;
  unsigned char* ws = p.ws;
  const float* xin = (l == 0) ? p.x : p.out;
  const float* mod = (const float*)(ws + OFF_MOD);
  const float* wg = (const float*)(ws + OFF_WG) + l * 8192;
  bf16_t* H = (bf16_t*)(ws + OFF_H);
  float* GI = (float*)(ws + OFF_GI);
  float* GF = (float*)(ws + OFF_GF);
  for (int it = item_begin; it < TOK / 4; it += item_stride) {
    const int tl = it * 4 + w, bl = tl >> 12, t = tl & 4095, bg = grp * 2 + bl;
    const float* xr = xin + ((size_t)grp * TOK + tl) * DM;
    f32x4 xv[4];
    float ss = 0.f;
#pragma unroll
    for (int i = 0; i < 4; ++i) { xv[i] = *(const f32x4*)(xr + 256 * i + 4 * lane); ss += xv[i][0] * xv[i][0] + xv[i][1] * xv[i][1] + xv[i][2] * xv[i][2] + xv[i][3] * xv[i][3]; }
    ss = wave_sum(ss);
    const float rstd = rsqrtf(ss * (1.0f / DM) + EPS);
    float ga[8];
#pragma unroll
    for (int j = 0; j < 8; ++j) ga[j] = 0.f;
    const float* mrow = mod + (l * 8 + bg) * 3072;
#pragma unroll
    for (int i = 0; i < 4; ++i) {
      const int col = 256 * i + 4 * lane;
      const f32x4 g = *(const f32x4*)(p.norm_g + l * DM + col), sh = *(const f32x4*)(mrow + col), sc = *(const f32x4*)(mrow + 1024 + col);
      float hv[4];
#pragma unroll
      for (int e = 0; e < 4; ++e) hv[e] = xv[i][e] * rstd * g[e] * (1.0f + sc[e]) + sh[e];
      u32x2 o; o[0] = pack2(hv[0], hv[1]); o[1] = pack2(hv[2], hv[3]);
      *(u32x2*)(H + (size_t)tl * DM + col) = o;
#pragma unroll
      for (int e = 0; e < 4; ++e) {
        const f32x4 w0 = *(const f32x4*)(wg + (col + e) * 8), w1 = *(const f32x4*)(wg + (col + e) * 8 + 4);
#pragma unroll
        for (int j = 0; j < 4; ++j) { ga[j] += hv[e] * w0[j]; ga[4 + j] += hv[e] * w1[j]; }
      }
    }
#pragma unroll
    for (int j = 0; j < 8; ++j) ga[j] = wave_sum(ga[j]);
    if (lane < 8) {
      float v = ga[0];
#pragma unroll
      for (int j = 1; j < 8; ++j) v = (lane == j) ? ga[j] : v;
      v += p.b_if[l * 8 + lane];
      const int hh = lane & 3;
      float* dst = (lane < 4) ? GI : GF;
      dst[(bl * 4 + hh) * 4096 + t] = v;
    }
  }
}

DI void gate_scan(const Params& p, int bh, float* sf) {
  const int tid = get_tid(), g = tid >> 3, j = tid & 7, t0 = tid * 16;
  unsigned char* ws = p.ws;
  const float* GI = (const float*)(ws + OFF_GI) + bh * 4096 + t0;
  const float* GF = (const float*)(ws + OFF_GF) + bh * 4096 + t0;
  float* s_cm = sf; float* s_bl = sf + 32; float* s_mp = sf + 64; float* s_mml = sf + 96;
  float a[16], b[16], cm[16];
#pragma unroll
  for (int q = 0; q < 4; ++q) {
    const f32x4 fv = *(const f32x4*)(GF + 4 * q), iv = *(const f32x4*)(GI + 4 * q);
#pragma unroll
    for (int e = 0; e < 4; ++e) { const float f = fv[e]; b[4 * q + e] = fminf(f, 0.f) - log1pf(__expf(-fabsf(f))); a[4 * q + e] = iv[e]; }
  }
  float s = 0.f;
#pragma unroll
  for (int k = 0; k < 16; ++k) { s += b[k]; b[k] = s; }
  float inc = s;
#pragma unroll
  for (int o = 1; o < 8; o <<= 1) { const float v = __shfl_up(inc, o, 8); if (j >= o) inc += v; }
  const float excl = inc - s;
  float m = -INFINITY;
#pragma unroll
  for (int k = 0; k < 16; ++k) { b[k] += excl; a[k] -= b[k]; m = fmaxf(m, a[k]); cm[k] = m; }
  float inc2 = m;
#pragma unroll
  for (int o = 1; o < 8; o <<= 1) { const float v = __shfl_up(inc2, o, 8); if (j >= o) inc2 = fmaxf(inc2, v); }
  float exm = __shfl_up(inc2, 1, 8);
  if (j == 0) exm = -INFINITY;
#pragma unroll
  for (int k = 0; k < 16; ++k) cm[k] = fmaxf(cm[k], exm);
  __syncthreads();
  if (j == 7) { s_cm[g] = cm[15]; s_bl[g] = b[15]; }
  __syncthreads();
  if (tid == 0) {
    float mp = 0.f;
    float* GDEC = (float*)(ws + OFF_GDEC) + bh * 32;
    for (int c = 0; c < 32; ++c) {
      s_mp[c] = mp;
      const float mml = fmaxf(mp, s_cm[c]);
      s_mml[c] = mml;
      GDEC[c] = __expf(mp - mml);
      mp = s_bl[c] + mml;
    }
  }
  __syncthreads();
  const float mp = s_mp[g], mml = s_mml[g];
  float* GA = (float*)(ws + OFF_GA) + bh * 4096 + t0;
  float* GMM = (float*)(ws + OFF_GMM) + bh * 4096 + t0;
  float* GWI = (float*)(ws + OFF_GWI) + bh * 4096 + t0;
  float* GEM = (float*)(ws + OFF_GEM) + bh * 4096 + t0;
  float* GWK = (float*)(ws + OFF_GWK) + bh * 4096 + t0;
#pragma unroll
  for (int q = 0; q < 4; ++q) {
    f32x4 va, vmm, vwi, vem, vwk;
#pragma unroll
    for (int e = 0; e < 4; ++e) {
      const int k = 4 * q + e;
      const float mm = fmaxf(mp, cm[k]);
      va[e] = a[k]; vmm[e] = mm; vwi[e] = __expf(mp - mm); vem[e] = __expf(-(b[k] + mm)); vwk[e] = __expf(a[k] - mml);
    }
    *(f32x4*)(GA + 4 * q) = va; *(f32x4*)(GMM + 4 * q) = vmm; *(f32x4*)(GWI + 4 * q) = vwi; *(f32x4*)(GEM + 4 * q) = vem; *(f32x4*)(GWK + 4 * q) = vwk;
  }
}

DI void inproj_tile(const Params& p, int l, int mt, int nt, bf16_t* sm) {
  unsigned char* ws = p.ws;
  const bf16_t* H = (const bf16_t*)(ws + OFF_H) + (size_t)mt * 128 * DM;
  const bf16_t* W = (const bf16_t*)(ws + OFF_WTIN) + ((size_t)l * NPK + (size_t)nt * 128) * 1024;
  const int n0 = nt * 128;
  bool tr = false; int dcol = 0; bf16_t* tb = nullptr;
  if (n0 < 2048) dcol = n0;
  else if (n0 < 4096) { tr = true; tb = (bf16_t*)(ws + OFF_VMT) + ((size_t)((mt >> 5) * 2048 + (n0 - 2048))) * 4096 + (mt & 31) * 128; }
  else if (n0 < 10240) dcol = n0 - 2048;
  else if (n0 < 11264) { tr = true; tb = (bf16_t*)(ws + OFF_VAT) + ((size_t)((mt >> 5) * 1024 + (n0 - 10240))) * 4096 + (mt & 31) * 128; }
  else dcol = n0 - 3072;
  f32x16 acc[2][2];
  acc_zero(acc);
  if (!tr) {
    gemm_core<false, true>(H, DM, W, 1024, 1024, acc, sm, nullptr, 0);
    bf16_t* dst = (bf16_t*)(ws + OFF_NAT) + (size_t)mt * 128 * NATW + dcol;
    {
      const int lane_ = get_tid() & 63, w_ = get_tid() >> 6, wm_ = w_ >> 1, wn_ = w_ & 1, r_ = lane_ & 31, h_ = lane_ >> 5;
#pragma unroll
      for (int i = 0; i < 2; ++i)
#pragma unroll
        for (int j = 0; j < 2; ++j)
#pragma unroll
          for (int gp = 0; gp < 2; ++gp) {
            const int g0 = 2 * gp, g1 = 2 * gp + 1;
            const unsigned a0 = pack2(acc[i][j][4 * g0], acc[i][j][4 * g0 + 1]), a1 = pack2(acc[i][j][4 * g0 + 2], acc[i][j][4 * g0 + 3]);
            const unsigned b0 = pack2(acc[i][j][4 * g1], acc[i][j][4 * g1 + 1]), b1 = pack2(acc[i][j][4 * g1 + 2], acc[i][j][4 * g1 + 3]);
            auto ra = __builtin_amdgcn_permlane32_swap(a0, b0, false, false);
            auto rb = __builtin_amdgcn_permlane32_swap(a1, b1, false, false);
            u32x4 o; o[0] = ra[0]; o[1] = rb[0]; o[2] = ra[1]; o[3] = rb[1];
            *(u32x4*)(dst + (size_t)(64 * wm_ + 32 * i + r_) * NATW + 64 * wn_ + 32 * j + 8 * (2 * gp + h_)) = o;
          }
    }
  } else {
    gemm_core<false, true>(W, 1024, H, DM, 1024, acc, sm, nullptr, 0);
    store_acc_bf16x8(acc, tb, 4096);
  }
}

DI void conv_item(const Params& p, int l, int idx, float* smf) {
  const int tid = get_tid(), cg = tid & 31, tg = tid >> 5;
  unsigned char* ws = p.ws;
  const int which = idx & 1, c = (idx >> 1) & 31, bh = idx >> 6, bl = bh >> 2, h = bh & 3;
  const int ch0 = which * 1024 + h * 256 + 8 * cg;
  float w[4][8], bias[8];
#pragma unroll
  for (int j = 0; j < 4; ++j) {
    const f32x4 a0 = *(const f32x4*)(p.conv_w + (l * 4 + j) * 2048 + ch0), a1 = *(const f32x4*)(p.conv_w + (l * 4 + j) * 2048 + ch0 + 4);
#pragma unroll
    for (int e = 0; e < 4; ++e) { w[j][e] = a0[e]; w[j][4 + e] = a1[e]; }
  }
  {
    const f32x4 a0 = *(const f32x4*)(p.conv_b + l * 2048 + ch0), a1 = *(const f32x4*)(p.conv_b + l * 2048 + ch0 + 4);
#pragma unroll
    for (int e = 0; e < 4; ++e) { bias[e] = a0[e]; bias[4 + e] = a1[e]; }
  }
  const int ts = c * 128 + 16 * tg;
  const bf16_t* src = (const bf16_t*)(ws + OFF_NAT) + (size_t)bl * 4096 * NATW + (which ? C_KM : C_QM) + h * 256 + 8 * cg;
  u32x4 raw[19];
#pragma unroll
  for (int i = 0; i < 19; ++i) {
    const int t = ts - 3 + i;
    if (t >= 0) raw[i] = *(const u32x4*)(src + (size_t)t * NATW);
    else raw[i] = (u32x4){0u, 0u, 0u, 0u};
  }
  bf16_t* OUT = (bf16_t*)(ws + (which ? OFF_KN : OFF_Q)) + (size_t)bl * 4096 * 1024 + h * 256 + 8 * cg;
  bf16_t* KT = (bf16_t*)(ws + OFF_KT) + (size_t)(bh * 256 + 8 * cg) * 4096 + ts;
  const float* GWK = (const float*)(ws + OFF_GWK) + bh * 4096 + ts;
  float nacc[8];
#pragma unroll
  for (int e = 0; e < 8; ++e) nacc[e] = 0.f;
  const float osc = which ? 0.0625f : 1.0f;
#pragma unroll
  for (int half = 0; half < 2; ++half) {
    float ks[8][8];
    f32x4 wk0, wk1;
    if (which) { wk0 = *(const f32x4*)(GWK + 8 * half); wk1 = *(const f32x4*)(GWK + 8 * half + 4); }
#pragma unroll
    for (int tt = 0; tt < 8; ++tt) {
      const int i = 8 * half + tt;
      float y[8];
#pragma unroll
      for (int q = 0; q < 4; ++q) {
        const unsigned r0 = raw[i][q], r1 = raw[i + 1][q], r2 = raw[i + 2][q], r3 = raw[i + 3][q];
        y[2 * q] = w[3][2 * q] * bflo(r3) + bias[2 * q] + w[0][2 * q] * bflo(r0) + w[1][2 * q] * bflo(r1) + w[2][2 * q] * bflo(r2);
        y[2 * q + 1] = w[3][2 * q + 1] * bfhi(r3) + bias[2 * q + 1] + w[0][2 * q + 1] * bfhi(r0) + w[1][2 * q + 1] * bfhi(r1) + w[2][2 * q + 1] * bfhi(r2);
      }
#pragma unroll
      for (int e = 0; e < 8; ++e) y[e] = siluf_(y[e]) * osc;
      u32x4 o; o[0] = pack2(y[0], y[1]); o[1] = pack2(y[2], y[3]); o[2] = pack2(y[4], y[5]); o[3] = pack2(y[6], y[7]);
      *(u32x4*)(OUT + (size_t)(ts + i) * 1024) = o;
      if (which) {
        const float wkv = tt < 4 ? wk0[tt & 3] : wk1[tt & 3];
#pragma unroll
        for (int e = 0; e < 8; ++e) { ks[tt][e] = y[e] * wkv; nacc[e] += ks[tt][e]; }
      }
    }
    if (which) {
#pragma unroll
      for (int e = 0; e < 8; ++e) {
        u32x4 o; o[0] = pack2(ks[0][e], ks[1][e]); o[1] = pack2(ks[2][e], ks[3][e]); o[2] = pack2(ks[4][e], ks[5][e]); o[3] = pack2(ks[6][e], ks[7][e]);
        *(u32x4*)(KT + (size_t)e * 4096 + 8 * half) = o;
      }
    }
  }
  if (which) {
    __syncthreads();
#pragma unroll
    for (int e = 0; e < 8; ++e) smf[tg * 256 + 8 * cg + e] = nacc[e];
    __syncthreads();
    float s = 0.f;
#pragma unroll
    for (int g = 0; g < 8; ++g) s += smf[g * 256 + tid];
    ((float*)(ws + OFF_NLOC))[(bh * 32 + c) * 256 + tid] = s;
  }
}

DI void state_chain(const Params& p, int idx, int rd, bf16_t* sm) {
  unsigned char* ws = p.ws;
  const int bh = idx >> 3, i2 = (idx >> 2) & 1, j4 = idx & 3, bl = bh >> 2, h = bh & 3;
  const bf16_t* VT = (const bf16_t*)(ws + OFF_VMT) + (size_t)(bl * 2048 + h * 512 + j4 * 128) * 4096;
  const bf16_t* KT = (const bf16_t*)(ws + OFF_KT) + (size_t)(bh * 256 + i2 * 128) * 4096;
  const float* GDEC = (const float*)(ws + OFF_GDEC) + bh * 32;
  bf16_t* dst0 = (bf16_t*)(ws + OFF_CST) + ((size_t)(bh * 32) * 512 + j4 * 128) * 256 + i2 * 128;
  f32x16 acc[2][2];
  acc_zero(acc);
  auto snap = [&](int c) {
    bf16_t* dst = dst0 + (size_t)c * 512 * 256;
    store_acc_bf16x8(acc, dst, 256);
  };
  gemm_core<false, true>(VT, 4096, KT, 4096, 31 * 128, acc, sm, nullptr, 0, [&](int kt) {
    if ((kt & 1) == 0) {
      const int c = kt >> 1;
      snap(c);
      const float dec = GDEC[c];
#pragma unroll
      for (int i = 0; i < 2; ++i)
#pragma unroll
        for (int j = 0; j < 2; ++j) acc[i][j] *= dec;
    }
  });
  snap(31);
  asm volatile("s_waitcnt vmcnt(0)" ::: "memory");
  __syncthreads();
  if (get_tid() == 0) {
    __builtin_amdgcn_fence(__ATOMIC_RELEASE, "agent");
    asm volatile("s_waitcnt vmcnt(0)" ::: "memory");
    __hip_atomic_fetch_add((unsigned*)(ws + OFF_CNT) + 256 + rd * 8 + bh, 1u, __ATOMIC_RELAXED, __HIP_MEMORY_SCOPE_AGENT);
  }
}

constexpr int LDP = 136;
DI void mlstm_out_item(const Params& p, int l, int idx, int rd, bf16_t* sm) {
  const int tid = get_tid(), lane = tid & 63, h5 = lane >> 5;
  unsigned char* ws = p.ws;
  const int bh = idx >> 5, c = idx & 31, bl = bh >> 2, h = bh & 3;
  const size_t tok0 = (size_t)bl * 4096 + c * 128;
  bf16_t* Ps = sm + CORE_SM;
  float* vec = (float*)(sm + CORE_SM + 128 * LDP);
  float *sa = vec, *smm = vec + 128, *swi = vec + 256, *sden = vec + 384, *ssq = vec + 512, *sn = vec + 640, *sgem = vec + 896;
  const bf16_t* Q = (const bf16_t*)(ws + OFF_Q) + tok0 * 1024 + h * 256;
  const bf16_t* KN = (const bf16_t*)(ws + OFF_KN) + tok0 * 1024 + h * 256;
  const float* GDEC = (const float*)(ws + OFF_GDEC) + bh * 32;
  const float* GEM = (const float*)(ws + OFF_GEM) + bh * 4096 + c * 128;
  if (tid == 0) {
    unsigned* dn = (unsigned*)(ws + OFF_CNT) + 256 + rd * 8 + bh;
    unsigned sp = 0;
    while (__hip_atomic_load(dn, __ATOMIC_RELAXED, __HIP_MEMORY_SCOPE_AGENT) < 8u) { __builtin_amdgcn_s_sleep(8); if (++sp > (1u << 22)) break; }
    __builtin_amdgcn_fence(__ATOMIC_ACQUIRE, "agent");
    asm volatile("s_waitcnt vmcnt(0)" ::: "memory");
  }
  __syncthreads();
  if (tid < 128) {
    sa[tid] = ((const float*)(ws + OFF_GA))[bh * 4096 + c * 128 + tid];
    smm[tid] = ((const float*)(ws + OFF_GMM))[bh * 4096 + c * 128 + tid];
    swi[tid] = ((const float*)(ws + OFF_GWI))[bh * 4096 + c * 128 + tid];
    sden[tid] = 0.f;
    ssq[tid] = 0.f;
    sgem[tid] = GEM[tid];
  }
  {
    float n = 0.f;
    const float* NL = (const float*)(ws + OFF_NLOC) + (size_t)bh * 32 * 256 + tid;
#pragma unroll 1
    for (int c0 = 0; c0 < c; c0 += 8) {
      float nv[8], dv[8];
#pragma unroll
      for (int q = 0; q < 8; ++q) { const int cc = c0 + q < c ? c0 + q : c - 1; nv[q] = NL[cc * 256]; dv[q] = GDEC[cc]; }
#pragma unroll
      for (int q = 0; q < 8; ++q) if (c0 + q < c) n = n * dv[q] + nv[q];
    }
    sn[tid] = n;
  }
  __syncthreads();
  {
    const int t = tid >> 1, half = tid & 1;
    const bf16_t* qr = Q + (size_t)t * 1024 + half * 128;
    float d = 0.f;
#pragma unroll 4
    for (int k = 0; k < 128; k += 8) {
      const u32x4 v = *(const u32x4*)(qr + k);
      const float* nn = sn + half * 128 + k;
      d += bflo(v[0]) * nn[0] + bfhi(v[0]) * nn[1] + bflo(v[1]) * nn[2] + bfhi(v[1]) * nn[3] + bflo(v[2]) * nn[4] + bfhi(v[2]) * nn[5] + bflo(v[3]) * nn[6] + bfhi(v[3]) * nn[7];
    }
    atomicAdd(&sden[t], swi[t] * d);
  }
  f32x16 acc[2][2];
  acc_zero(acc);
  gemm_core<false, false>(Q, 1024, KN, 1024, 256, acc, sm, nullptr, 0);
  {
    float psum[2] = {0.f, 0.f};
    const int w = tid >> 6, wm = w >> 1, r = lane & 31;
    for_quads(acc, [&](int ar, int br, int ii, float v0, float v1, float v2, float v3) {
      const float mt = smm[ar];
      const f32x4 av = *(const f32x4*)(sa + br);
      const float p0 = (br + 0 <= ar) ? v0 * __expf(av[0] - mt) : 0.f;
      const float p1 = (br + 1 <= ar) ? v1 * __expf(av[1] - mt) : 0.f;
      const float p2 = (br + 2 <= ar) ? v2 * __expf(av[2] - mt) : 0.f;
      const float p3 = (br + 3 <= ar) ? v3 * __expf(av[3] - mt) : 0.f;
      psum[ii] += (p0 + p1) + (p2 + p3);
      u32x2 o; o[0] = pack2(p0, p1); o[1] = pack2(p2, p3);
      *(u32x2*)(Ps + ar * LDP + br) = o;
    });
#pragma unroll
    for (int i = 0; i < 2; ++i) {
      float s = psum[i];
      s += __shfl_xor(s, 32);
      if (h5 == 0) atomicAdd(&sden[64 * wm + 32 * i + r], s);
    }
  }
  __syncthreads();
  const bf16_t* OMp = (const bf16_t*)(ws + OFF_NAT) + tok0 * NATW + C_OM + h * 512;
  const bf16_t* ZMp = (const bf16_t*)(ws + OFF_NAT) + tok0 * NATW + C_ZM + h * 512;
  bf16_t* HMp = (bf16_t*)(ws + OFF_HM) + tok0 * 2048 + h * 512;
  bf16_t* Ht = sm;
  const int row = tid >> 1, hf = tid & 1;
  float sq = 0.f;
#pragma unroll 1
  for (int j4 = 0; j4 < 4; ++j4) {
    acc_zero(acc);
    if (c > 0) {
      gemm_core<false, false>(Q, 1024, (const bf16_t*)(ws + OFF_CST) + ((size_t)(bh * 32 + c) * 512 + j4 * 128) * 256, 256, 256, acc, sm, nullptr, 0);
      for_quads(acc, [&](int ar, int br, int ii, float& v0, float& v1, float& v2, float& v3) { const float s = swi[ar]; v0 *= s; v1 *= s; v2 *= s; v3 *= s; });
    }
    gemm_core<true, false>(nullptr, 0, (const bf16_t*)(ws + OFF_VMT) + (size_t)(bl * 2048 + h * 512 + j4 * 128) * 4096 + c * 128, 4096, 128, acc, sm, Ps, LDP);
    __syncthreads();
    for_quads(acc, [&](int ar, int br, int ii, float v0, float v1, float v2, float v3) {
      const float den = 1.0f / fmaxf(fabsf(sden[ar]), sgem[ar]);
      u32x2 o; o[0] = pack2(v0 * den, v1 * den); o[1] = pack2(v2 * den, v3 * den);
      *(u32x2*)(Ht + ar * LDP + br) = o;
    });
    __syncthreads();
#pragma unroll
    for (int q = 0; q < 8; ++q) {
      const int dv0 = hf * 64 + q * 8;
      const u32x4 hv = *(const u32x4*)(Ht + row * LDP + dv0);
      const u32x4 ov = *(const u32x4*)(OMp + (size_t)row * NATW + j4 * 128 + dv0);
      const u32x4 zv = *(const u32x4*)(ZMp + (size_t)row * NATW + j4 * 128 + dv0);
      const f32x4 g0 = *(const f32x4*)(p.mnorm_g + l * 2048 + h * 512 + j4 * 128 + dv0), g1 = *(const f32x4*)(p.mnorm_g + l * 2048 + h * 512 + j4 * 128 + dv0 + 4);
      u32x4 o;
#pragma unroll
      for (int e = 0; e < 4; ++e) {
        const float x0 = bflo(hv[e]) * sigmoidf_(bflo(ov[e])), x1 = bfhi(hv[e]) * sigmoidf_(bfhi(ov[e]));
        sq += x0 * x0 + x1 * x1;
        const float ga = e < 2 ? g0[2 * e] : g1[2 * e - 4], gb = e < 2 ? g0[2 * e + 1] : g1[2 * e - 3];
        o[e] = pack2(x0 * ga * siluf_(bflo(zv[e])), x1 * gb * siluf_(bfhi(zv[e])));
      }
      *(u32x4*)(HMp + (size_t)row * 2048 + j4 * 128 + dv0) = o;
    }
  }
  sq += __shfl_xor(sq, 1);
  if (hf == 0) ((float*)(ws + OFF_RS))[(tok0 + row) * 4 + h] = rsqrtf(sq * (1.0f / 512.0f) + EPS);
}

#define MFMA16(a, b, c) __builtin_amdgcn_mfma_f32_16x16x32_bf16((a), (b), (c), 0, 0, 0)
DI void attn_item(const Params& p, int l, int bl, int hd, int qb, bf16_t* sm) {
  const int tid = get_tid(), lane = tid & 63, w = tid >> 6, r16 = lane & 15, q4 = lane >> 4;
  unsigned char* ws = p.ws;
  bf16_t* Ks = sm;
  bf16_t* Vs = sm + 2 * 64 * LDT;
  float* tb = (float*)(sm + 2 * 64 * LDT + 128 * LDT);
  const bf16_t* NAT = (const bf16_t*)(ws + OFF_NAT) + (size_t)bl * 4096 * NATW;
  const bf16_t* VT = (const bf16_t*)(ws + OFF_VAT) + (size_t)(bl * 1024 + hd * 128) * 4096;
  const int wu = __builtin_amdgcn_readfirstlane(w);
  const int Q0 = qb * 64, t0 = Q0 + 16 * wu, t = t0 + r16;
  float lam;
  {
    float s1 = 0.f, s2 = 0.f;
    for (int i = 0; i < 64; ++i) { s1 += p.lam_q1[l * 64 + i] * p.lam_k1[l * 64 + i]; s2 += p.lam_q2[l * 64 + i] * p.lam_k2[l * 64 + i]; }
    lam = __expf(s1) - __expf(s2) + (l == 0 ? 0.2f : 0.35550906f);
  }
  const float oml = (l == 0) ? 0.8f : 0.64449094f;
  __syncthreads();
  if (tid < 129) {
    int bucket;
    if (tid < 16) bucket = tid;
    else { const float v = logf((float)tid / 16.0f) / 2.0794415416798357f * 16.0f; bucket = 16 + (int)v; if (bucket > 31) bucket = 31; }
    tb[tid] = p.rel_bias[bucket * 8 + hd] * LOG2E;
  }
  bf16_t* Qs = sm + 2 * 64 * LDT + 128 * LDT + 512;
#pragma unroll
  for (int pp = 0; pp < 4; ++pp) {
    const int id = tid + 256 * pp, row = id >> 4, ch = id & 15;
    *(u32x4*)(Qs + row * LDP + ch * 8) = *(const u32x4*)(NAT + (size_t)(Q0 + row) * NATW + C_QA + hd * 128 + ch * 8);
  }
  f32x4 O[2][8];
#pragma unroll
  for (int m = 0; m < 2; ++m)
#pragma unroll
    for (int jd = 0; jd < 8; ++jd)
#pragma unroll
      for (int e = 0; e < 4; ++e) O[m][jd][e] = 0.f;
  float Mx[2] = {-INFINITY, -INFINITY}, Ls[2] = {0.f, 0.f};
  const int ntile = qb + 1;
  const float c1 = 0.125f * LOG2E;
  u32x4 rk[4], rv[4];
#pragma unroll
  for (int pp = 0; pp < 4; ++pp) {
    const int id = tid + 256 * pp;
    rk[pp] = *(const u32x4*)(NAT + (size_t)((id >> 3) & 63) * NATW + C_KA + hd * 128 + (id >> 9) * 64 + (id & 7) * 8);
    rv[pp] = *(const u32x4*)(VT + (size_t)(id >> 3) * 4096 + (id & 7) * 8);
  }
#pragma unroll 1
  for (int kt = 0; kt < ntile; ++kt) {
    const int s0 = kt * 64;
    __syncthreads();
#pragma unroll
    for (int pp = 0; pp < 4; ++pp) {
      const int id = tid + 256 * pp;
      *(u32x4*)(Ks + ((id >> 9) * 64 + ((id >> 3) & 63)) * LDT + (id & 7) * 8) = rk[pp];
      *(u32x4*)(Vs + (id >> 3) * LDT + (id & 7) * 8) = rv[pp];
    }
    __syncthreads();
    if (kt + 1 < ntile) {
#pragma unroll
      for (int pp = 0; pp < 4; ++pp) {
        const int id = tid + 256 * pp;
        rk[pp] = *(const u32x4*)(NAT + (size_t)(s0 + 64 + ((id >> 3) & 63)) * NATW + C_KA + hd * 128 + (id >> 9) * 64 + (id & 7) * 8);
        rv[pp] = *(const u32x4*)(VT + (size_t)(id >> 3) * 4096 + s0 + 64 + (id & 7) * 8);
      }
    }
    if (s0 <= t0 + 15) {
      const bool nearb = (s0 + 63 + 128 > t0);
      const float tb128 = tb[128];
      u32x4 pk[2][2];
#pragma unroll
      for (int m = 0; m < 2; ++m) {
        f32x4 sacc[4];
#pragma unroll
        for (int st = 0; st < 4; ++st) {
#pragma unroll
          for (int e = 0; e < 4; ++e) sacc[st][e] = 0.f;
#pragma unroll
          for (int kk = 0; kk < 2; ++kk) {
            const bf16x8 a = *(const bf16x8*)(Ks + (m * 64 + 16 * st + r16) * LDT + kk * 32 + 8 * q4);
            const bf16x8 qfr = *(const bf16x8*)(Qs + (16 * wu + r16) * LDP + m * 64 + kk * 32 + 8 * q4);
            sacc[st] = MFMA16(a, qfr, sacc[st]);
          }
        }
        float alpha, ps = 0.f;
        if (!nearb) {
          float mx = fmaxf(fmaxf(sacc[0][0], sacc[0][1]), fmaxf(sacc[0][2], sacc[0][3]));
#pragma unroll
          for (int st = 1; st < 4; ++st) mx = fmaxf(mx, fmaxf(fmaxf(sacc[st][0], sacc[st][1]), fmaxf(sacc[st][2], sacc[st][3])));
          float Mn = Mx[m];
          alpha = 1.0f;
          if (__builtin_amdgcn_ballot_w64(mx * c1 + tb128 - Mn > 8.0f) != 0ull) {
            mx = fmaxf(mx, __shfl_xor(mx, 16));
            mx = fmaxf(mx, __shfl_xor(mx, 32));
            Mn = fmaxf(Mn, mx * c1 + tb128); alpha = __builtin_amdgcn_exp2f(Mx[m] - Mn); Mx[m] = Mn;
          }
          const float off = tb128 - Mn;
#pragma unroll
          for (int st = 0; st < 4; ++st)
#pragma unroll
            for (int e = 0; e < 4; ++e) { const float pv = __builtin_amdgcn_exp2f(sacc[st][e] * c1 + off); sacc[st][e] = pv; ps += pv; }
        } else {
          float mx = -INFINITY;
#pragma unroll
          for (int st = 0; st < 4; ++st)
#pragma unroll
            for (int e = 0; e < 4; ++e) {
              const int s = s0 + 16 * st + 4 * q4 + e;
              const int rel = t - s;
              int ri = rel < 0 ? 0 : rel; ri = ri > 128 ? 128 : ri;
              float xv = sacc[st][e] * c1 + tb[ri];
              if (rel < 0) xv = -INFINITY;
              sacc[st][e] = xv;
              mx = fmaxf(mx, xv);
            }
          float Mn = Mx[m];
          alpha = 1.0f;
          if (__builtin_amdgcn_ballot_w64(mx - Mn > 8.0f) != 0ull) {
            mx = fmaxf(mx, __shfl_xor(mx, 16));
            mx = fmaxf(mx, __shfl_xor(mx, 32));
            Mn = fmaxf(Mn, mx); alpha = __builtin_amdgcn_exp2f(Mx[m] - Mn); Mx[m] = Mn;
          }
#pragma unroll
          for (int st = 0; st < 4; ++st)
#pragma unroll
            for (int e = 0; e < 4; ++e) { const float pv = __builtin_amdgcn_exp2f(sacc[st][e] - Mn); sacc[st][e] = pv; ps += pv; }
        }
        Ls[m] = Ls[m] * alpha + ps;
        if (__builtin_amdgcn_ballot_w64(alpha != 1.0f) != 0ull) {
#pragma unroll
          for (int jd = 0; jd < 8; ++jd) O[m][jd] *= alpha;
        }
#pragma unroll
        for (int u = 0; u < 2; ++u) {
          pk[m][u][0] = pack2(sacc[2 * u][0], sacc[2 * u][1]); pk[m][u][1] = pack2(sacc[2 * u][2], sacc[2 * u][3]);
          pk[m][u][2] = pack2(sacc[2 * u + 1][0], sacc[2 * u + 1][1]); pk[m][u][3] = pack2(sacc[2 * u + 1][2], sacc[2 * u + 1][3]);
        }
        __builtin_amdgcn_sched_barrier(0);
      }
#pragma unroll
      for (int u = 0; u < 2; ++u) {
        const bf16x8 pf0 = __builtin_bit_cast(bf16x8, pk[0][u]), pf1 = __builtin_bit_cast(bf16x8, pk[1][u]);
#pragma unroll
        for (int jd = 0; jd < 8; ++jd) {
          if ((jd & 3) == 0) asm volatile("" ::: "memory");
          const bf16_t* vp = Vs + (16 * jd + r16) * LDT + 32 * u + 4 * q4;
          const s16x4 lo = *(const s16x4*)vp, hi = *(const s16x4*)(vp + 16);
          const bf16x8 vf = __builtin_shufflevector(lo, hi, 0, 1, 2, 3, 4, 5, 6, 7);
          O[0][jd] = MFMA16(vf, pf0, O[0][jd]);
          O[1][jd] = MFMA16(vf, pf1, O[1][jd]);
        }
      }
    }
  }
  float L1 = Ls[0], L2 = Ls[1];
  L1 += __shfl_xor(L1, 16); L1 += __shfl_xor(L1, 32);
  L2 += __shfl_xor(L2, 16); L2 += __shfl_xor(L2, 32);
  const float i1 = 1.0f / L1, i2 = lam / L2;
  float ss = 0.f;
#pragma unroll
  for (int jd = 0; jd < 8; ++jd)
#pragma unroll
    for (int e = 0; e < 4; ++e) { const float o = O[0][jd][e] * i1 - O[1][jd][e] * i2; O[0][jd][e] = o; ss += o * o; }
  ss += __shfl_xor(ss, 16); ss += __shfl_xor(ss, 32);
  const float rs = rsqrtf(ss * (1.0f / 128.0f) + EPS) * oml;
  const bf16_t* ZA = NAT + (size_t)t * NATW + C_ZA + hd * 128;
  bf16_t* HA = (bf16_t*)(ws + OFF_HA) + ((size_t)bl * 4096 + t) * 1024 + hd * 128;
  const float* ag = p.anorm_g + l * 1024 + hd * 128;
#pragma unroll
  for (int jd = 0; jd < 8; ++jd) {
    const int dv = 16 * jd + 4 * q4;
    const u32x2 zv = *(const u32x2*)(ZA + dv);
    const f32x4 gg = *(const f32x4*)(ag + dv);
    u32x2 o;
    o[0] = pack2(O[0][jd][0] * rs * gg[0] * siluf_(bflo(zv[0])), O[0][jd][1] * rs * gg[1] * siluf_(bfhi(zv[0])));
    o[1] = pack2(O[0][jd][2] * rs * gg[2] * siluf_(bflo(zv[1])), O[0][jd][3] * rs * gg[3] * siluf_(bfhi(zv[1])));
    *(u32x2*)(HA + dv) = o;
  }
}

DI void proj_tile(const Params& p, int l, int mt, int nt, bf16_t* sm) {
  unsigned char* ws = p.ws;
  f32x16 acc[2][2];
  acc_zero(acc);
  f32x4 rsv[2];
  {
    const int lane_ = get_tid() & 63, w_ = get_tid() >> 6;
#pragma unroll
    for (int i = 0; i < 2; ++i) rsv[i] = *(const f32x4*)((const float*)(ws + OFF_RS) + ((size_t)mt * 128 + 64 * (w_ >> 1) + 32 * i + (lane_ & 31)) * 4);
  }
  gemm_core<false, true>((const bf16_t*)(ws + OFF_HM) + (size_t)mt * 128 * 2048, 2048, (const bf16_t*)(ws + OFF_WTPM) + ((size_t)l * 1024 + nt * 128) * 2048, 2048, 2048, acc, sm, nullptr, 0, [&](int kt) {
    if (kt == 8) {
#pragma unroll
      for (int i = 0; i < 2; ++i) { const float f = rsv[i][0] / rsv[i][1]; acc[i][0] *= f; acc[i][1] *= f; }
    } else if (kt == 16) {
#pragma unroll
      for (int i = 0; i < 2; ++i) { const float f = rsv[i][1] / rsv[i][2]; acc[i][0] *= f; acc[i][1] *= f; }
    } else if (kt == 24) {
#pragma unroll
      for (int i = 0; i < 2; ++i) { const float f = rsv[i][2] / rsv[i][3]; acc[i][0] *= f; acc[i][1] *= f; }
    }
  });
#pragma unroll
  for (int i = 0; i < 2; ++i) { acc[i][0] *= rsv[i][3]; acc[i][1] *= rsv[i][3]; }
  const bf16_t* G = (const bf16_t*)(ws + OFF_NAT) + (size_t)mt * 128 * NATW + nt * 128;
  for_quads(acc, [&](int ar, int br, int ii, float& v0, float& v1, float& v2, float& v3) {
    const u32x2 gm = *(const u32x2*)(G + (size_t)ar * NATW + C_GM + br), ga = *(const u32x2*)(G + (size_t)ar * NATW + C_GA + br);
    v0 *= (1.0f + __expf(-bflo(ga[0]))) / (1.0f + __expf(-bflo(gm[0])));
    v1 *= (1.0f + __expf(-bfhi(ga[0]))) / (1.0f + __expf(-bfhi(gm[0])));
    v2 *= (1.0f + __expf(-bflo(ga[1]))) / (1.0f + __expf(-bflo(gm[1])));
    v3 *= (1.0f + __expf(-bfhi(ga[1]))) / (1.0f + __expf(-bfhi(gm[1])));
  });
  gemm_core<false, true>((const bf16_t*)(ws + OFF_HA) + (size_t)mt * 128 * 1024, 1024, (const bf16_t*)(ws + OFF_WTPA) + ((size_t)l * 1024 + nt * 128) * 1024, 1024, 1024, acc, sm, nullptr, 0);
  bf16_t* Y = (bf16_t*)(ws + OFF_Q) + (size_t)mt * 128 * 1024 + nt * 128;
  for_quads(acc, [&](int ar, int br, int ii, float& v0, float& v1, float& v2, float& v3) {
    const u32x2 ga = *(const u32x2*)(G + (size_t)ar * NATW + C_GA + br);
    v0 *= sigmoidf_(bflo(ga[0])); v1 *= sigmoidf_(bfhi(ga[0])); v2 *= sigmoidf_(bflo(ga[1])); v3 *= sigmoidf_(bfhi(ga[1]));
  });
  store_acc_bf16x8(acc, Y, 1024);
}

DI void out_tile(const Params& p, int l, int grp, int mt, int nt, bf16_t* sm) {
  unsigned char* ws = p.ws;
  f32x16 acc[2][2];
  acc_zero(acc);
  gemm_core<false, true>((const bf16_t*)(ws + OFF_Q) + (size_t)mt * 128 * 1024, 1024, (const bf16_t*)(ws + OFF_WTOUT) + ((size_t)l * 1024 + nt * 128) * 1024, 1024, 1024, acc, sm, nullptr, 0);
  const float* xin = ((l == 0) ? p.x : p.out) + ((size_t)grp * TOK + mt * 128) * DM + nt * 128;
  float* xo = p.out + ((size_t)grp * TOK + mt * 128) * DM + nt * 128;
  const float* gate = (const float*)(ws + OFF_MOD) + (l * 8 + grp * 2 + (mt >> 5)) * 3072 + 2048 + nt * 128;
  for_quads(acc, [&](int ar, int br, int ii, float v0, float v1, float v2, float v3) {
    const f32x4 xv = *(const f32x4*)(xin + (size_t)ar * DM + br);
    const f32x4 gv = *(const f32x4*)(gate + br);
    f32x4 o; o[0] = xv[0] + gv[0] * v0; o[1] = xv[1] + gv[1] * v1; o[2] = xv[2] + gv[2] * v2; o[3] = xv[3] + gv[3] * v3;
    *(f32x4*)(xo + (size_t)ar * DM + br) = o;
  });
}

DI void final_norm(const Params& p) {
  const int tid = get_tid(), lane = tid & 63, w = tid >> 6;
  for (int it = blockIdx.x; it < NBATCH * SEQ / 4; it += gridDim.x) {
    float* xr = p.out + ((size_t)it * 4 + w) * DM;
    f32x4 xv[4];
    float ss = 0.f;
#pragma unroll
    for (int i = 0; i < 4; ++i) { xv[i] = *(const f32x4*)(xr + 256 * i + 4 * lane); ss += xv[i][0] * xv[i][0] + xv[i][1] * xv[i][1] + xv[i][2] * xv[i][2] + xv[i][3] * xv[i][3]; }
    ss = wave_sum(ss);
    const float rstd = rsqrtf(ss * (1.0f / DM) + EPS);
#pragma unroll
    for (int i = 0; i < 4; ++i) {
      const f32x4 g = *(const f32x4*)(p.final_g + 256 * i + 4 * lane);
      f32x4 o; o[0] = xv[i][0] * rstd * g[0]; o[1] = xv[i][1] * rstd * g[1]; o[2] = xv[i][2] * rstd * g[2]; o[3] = xv[i][3] * rstd * g[3];
      *(f32x4*)(xr + 256 * i + 4 * lane) = o;
    }
  }
}


#define XB_TMO      128
#define XB_XCNT(j)  (256  + 64 * (j))
#define XB_XSUB(j)  (1280 + 64 * (j))
#define XB_XGEN(j)  (2304 + 64 * (j))
#define XB_TOP      3328
#define XB_TOPGEN   3392
#define XCD_BAR_WORDS 3456
#define XB_SPIN_CAP (1u << 22)
#define LAS __attribute__((address_space(3)))
DI unsigned xb_ld(unsigned* p) { return __hip_atomic_load(p, __ATOMIC_RELAXED, __HIP_MEMORY_SCOPE_AGENT); }
DI unsigned xb_add(unsigned* p, unsigned v) { return __hip_atomic_fetch_add(p, v, __ATOMIC_RELAXED, __HIP_MEMORY_SCOPE_AGENT); }
DI unsigned xb_xcc_id() { return (unsigned)__builtin_amdgcn_s_getreg((3 << 11) | 20) & 0xFu; }
#define XB_SPIN(cond, bar) do { unsigned _sp = 0; while (cond) { __builtin_amdgcn_s_sleep(1); \
    if ((++_sp & 255u) == 0u) { if (xb_ld(&(bar)[XB_TMO])) break; if (_sp > XB_SPIN_CAP) { atomicAdd(&(bar)[XB_TMO], 1u); break; } } } } while (0)
struct XcdBarrier { unsigned* bar; unsigned x; volatile LAS unsigned* st; };
DI XcdBarrier xcd_barrier_post(unsigned* bar, volatile LAS unsigned* st) {
  XcdBarrier b; b.bar = bar; b.x = xb_xcc_id(); b.st = st;
  if (threadIdx.x == 0) (void)xb_add(&bar[XB_XCNT(b.x)], 1u);
  return b;
}
DI void xcd_barrier_complete(unsigned* bar, unsigned x, unsigned& nloc, unsigned& nx) {
  const unsigned G = gridDim.x * gridDim.y * gridDim.z;
  unsigned sum, cnt, mine, sp = 0u;
  for (;;) {
    sum = 0u; cnt = 0u; mine = 0u;
#pragma unroll
    for (unsigned j = 0; j < 16; ++j) { const unsigned c = xb_ld(&bar[XB_XCNT(j)]); sum += c; cnt += (c > 0u) ? 1u : 0u; mine = (j == x) ? c : mine; }
    if (sum == G) break;
    __builtin_amdgcn_s_sleep(1);
    if ((++sp & 255u) == 0u) { if (xb_ld(&bar[XB_TMO])) break; if (sp > XB_SPIN_CAP) { atomicAdd(&bar[XB_TMO], 1u); break; } }
  }
  nloc = mine > 0u ? mine : 1u; nx = cnt > 0u ? cnt : 1u;
}
DI void xcd_barrier(const XcdBarrier& b) {
  asm volatile("s_waitcnt vmcnt(0)" ::: "memory");
  __syncthreads();
  if (threadIdx.x == 0) {
    unsigned* bar = b.bar;
    __builtin_amdgcn_s_waitcnt(0);
    unsigned nloc = b.st[0], nx = b.st[1];
    if (nloc == 0u) { xcd_barrier_complete(bar, b.x, nloc, nx); b.st[0] = nloc; b.st[1] = nx; }
    const unsigned old = xb_add(&bar[XB_XSUB(b.x)], 1u);
    const unsigned gen = old / nloc;
    if (old + 1u == (gen + 1u) * nloc) {
      __builtin_amdgcn_fence(__ATOMIC_RELEASE, "agent");
      asm volatile("s_waitcnt vmcnt(0)" ::: "memory");
      const unsigned og = xb_add(&bar[XB_TOP], 1u);
      const unsigned tg = og / nx;
      if (og + 1u == (tg + 1u) * nx) xb_add(&bar[XB_TOPGEN], 1u);
      else XB_SPIN(xb_ld(&bar[XB_TOPGEN]) == tg, bar);
      __builtin_amdgcn_fence(__ATOMIC_ACQUIRE, "agent");
      xb_add(&bar[XB_XGEN(b.x)], 1u);
      asm volatile("s_waitcnt vmcnt(0)" ::: "memory");
    } else {
      XB_SPIN(xb_ld(&bar[XB_XGEN(b.x)]) == gen, bar);
      __builtin_amdgcn_fence(__ATOMIC_ACQUIRE, "agent");
      asm volatile("s_waitcnt vmcnt(0)" ::: "memory");
    }
  }
  __syncthreads();
}

constexpr int SMEM_BYTES = (CORE_SM + 128 * LDP) * 2 + 1024 * 4;

__global__ void __launch_bounds__(256, 2) fwd_megakernel(Params p) {
  cg::grid_group grid = cg::this_grid();
#define GSYNC() xcd_barrier(xb)
  extern __shared__ __attribute__((aligned(16))) unsigned char smem_raw[];
  bf16_t* sm = (bf16_t*)smem_raw;
  __shared__ __attribute__((aligned(16))) unsigned s_static[8];
#define s_item (*(volatile int*)&s_static[4])
  const int tid = get_tid();
  int* cnt = (int*)(p.ws + OFF_CNT);
#ifdef PROBE_SEL_A
  float tacc[8] = {0.f, 0.f, 0.f, 0.f, 0.f, 0.f, 0.f, 0.f};
  unsigned long long tlast = wall_clock64();
#define TS(k) { const unsigned long long now_ = wall_clock64(); tacc[k] += (float)(now_ - tlast); tlast = now_; }
#elif defined(PROBE_AMP)
  unsigned long long tlast = wall_clock64();
#define TS(k) { if (blockIdx.x == 0) { const unsigned long long now_ = wall_clock64(); if ((k) == PROBE_AMP) { const unsigned long long dt_ = now_ - tlast; while (wall_clock64() - now_ < 4ull * dt_) __builtin_amdgcn_s_sleep(16); } tlast = wall_clock64(); } }
#else
#define TS(k)
#endif

  if (threadIdx.x < 8) s_static[threadIdx.x] = 0u;
  __syncthreads();
  XcdBarrier xb = xcd_barrier_post((unsigned*)(p.ws + OFF_BAR), (volatile LAS unsigned*)s_static);
  phase0(p, (float*)smem_raw);
#ifdef DBL_P0
  phase0(p, (float*)smem_raw);
#endif
  grid.sync();
  norm_rows(p, 0, 0, blockIdx.x, gridDim.x);
  GSYNC();
  TS(0)

  for (int rd = 0; rd < 8; ++rd) {
    const int l = rd >> 2;
    if (blockIdx.x < 8) gate_scan(p, blockIdx.x, (float*)smem_raw);
    if (rd > 0) for (int it = blockIdx.x; it < 512; it += gridDim.x) out_tile(p, (rd - 1) >> 2, (rd - 1) & 3, it & 63, it >> 6, sm);
#ifdef DBL_B
    for (int rep = 0; rep < 2; ++rep)
#endif
    for (int it = blockIdx.x; it < 64 * 112; it += gridDim.x) inproj_tile(p, l, it & 63, it >> 6, sm);
    GSYNC();
    TS(1)
#ifdef DBL_CONV
    for (int rep = 0; rep < 2; ++rep)
#endif
    for (int it = blockIdx.x; it < 512; it += gridDim.x) conv_item(p, l, it, (float*)smem_raw);
    if (rd < 7) norm_rows(p, (rd + 1) >> 2, (rd + 1) & 3, blockIdx.x, gridDim.x);
    GSYNC();
    TS(2)
#ifdef DBL_C1
    for (int rep = 0; rep < 2; ++rep)
#else
    const int rep = 0;
#endif
    for (;;) {
      const int rdx = rd + 8 * rep;
      __syncthreads();
      if (tid == 0) s_item = atomicAdd(&cnt[rdx * 16], 1);
      __syncthreads();
      const int it = s_item;
      if (it >= 64 + 1024 + 256) break;
      if (it < 64) state_chain(p, it, rdx, sm);
      else if (it < 448 || it >= 704) {
        int k, qb;
        if (it < 448) { k = it - 64; qb = 63 - (k >> 4); }
        else { k = it - 704; qb = 39 - (k >> 4); }
        attn_item(p, l, (k >> 3) & 1, k & 7, qb, sm);
      } else mlstm_out_item(p, l, it - 448, rdx, sm);
    }
    GSYNC();
    TS(4)
#ifdef DBL_PROJ
    for (int rep = 0; rep < 2; ++rep)
#endif
    for (int it = blockIdx.x; it < 512; it += gridDim.x) proj_tile(p, l, it & 63, it >> 6, sm);
    GSYNC();
    TS(5)
  }
  for (int it = blockIdx.x; it < 512; it += gridDim.x) out_tile(p, 1, 3, it & 63, it >> 6, sm);
  GSYNC();
  TS(6)
  final_norm(p);
#ifdef PROBE_SEL_A
  TS(7)
  __syncthreads();
  if (blockIdx.x == 0 && tid == 0) { p.out[0] += tacc[PROBE_SEL_A] * 0.01f; p.out[1] += tacc[PROBE_SEL_B] * 0.01f; }
#endif
}

extern "C" void kernel_launch(void* const* d_in, const int* in_sizes, int n_in, void* d_out, int out_size, void* d_ws, size_t ws_size, hipStream_t stream) {
  static int grid_blocks = 0;
  if (!grid_blocks) {
    int dev = 0, cus = 0, per_cu = 0;
    hipGetDevice(&dev);
    hipDeviceGetAttribute(&cus, hipDeviceAttributeMultiprocessorCount, dev);
    hipFuncSetAttribute((const void*)fwd_megakernel, hipFuncAttributeMaxDynamicSharedMemorySize, SMEM_BYTES);
    hipOccupancyMaxActiveBlocksPerMultiprocessor(&per_cu, (const void*)fwd_megakernel, 256, SMEM_BYTES);
    if (per_cu < 1) per_cu = 1;
    if (per_cu > 2) per_cu = 2;
    grid_blocks = cus * per_cu;
    if (ws_size < WS_END) fprintf(stderr, "kernel_launch: workspace too small: %zu < %zu\n", ws_size, (size_t)WS_END);
  }
  Params p{};
  const float** pp = (const float**)&p;
  for (int i = 0; i < 20; ++i) pp[i] = (const float*)d_in[i];
  p.out = (float*)d_out;
  p.ws = (unsigned char*)d_ws;
  hipMemsetAsync(d_ws, 0, 20480, stream);
  void* args[] = {&p};
  hipError_t e = hipLaunchCooperativeKernel((const void*)fwd_megakernel, dim3(grid_blocks), dim3(256), args, SMEM_BYTES, stream);
  if (e != hipSuccess) fprintf(stderr, "cooperative launch failed: %s (grid %d)\n", hipGetErrorString(e), grid_blocks);
}
```

```cpp
#include <hip/hip_runtime.h>
#define SGB 1
#include <hip/hip_cooperative_groups.h>
#include <cstdio>
#include <cstdint>
namespace cg = cooperative_groups;

typedef unsigned short bf16_t;
typedef short bf16x8 __attribute__((ext_vector_type(8)));
typedef short s16x4 __attribute__((ext_vector_type(4)));
typedef float f32x16 __attribute__((ext_vector_type(16)));
typedef float f32x4 __attribute__((ext_vector_type(4)));
typedef unsigned u32x4 __attribute__((ext_vector_type(4)));
typedef unsigned u32x2 __attribute__((ext_vector_type(2)));
#define DI __device__ __forceinline__
#define MFMA32(a, b, c) __builtin_amdgcn_mfma_f32_32x32x16_bf16((a), (b), (c), 0, 0, 0)

constexpr int DM = 1024, SEQ = 4096, NBATCH = 8, TOK = 8192  , NIN = 14344, NPK = 14336, NATW = 11264;
constexpr int C_QM = 0, C_KM = 1024, C_OM = 2048, C_ZM = 4096, C_QA = 6144, C_KA = 7168, C_ZA = 8192, C_GM = 9216, C_GA = 10240;
constexpr float EPS = 1e-6f, LOG2E = 1.4426950408889634f;

constexpr size_t al256(size_t x) { return (x + 255) & ~(size_t)255; }
constexpr size_t OFF_CNT = 0;
constexpr size_t OFF_BAR = 4096;
constexpr size_t OFF_MOD = 20480;
constexpr size_t OFF_WG = OFF_MOD + al256(2 * 8 * 3072 * 4);
constexpr size_t OFF_GI = OFF_WG + al256(2 * 1024 * 8 * 4);
constexpr size_t OFF_GF = OFF_GI + 131072;
constexpr size_t OFF_GA = OFF_GF + 131072;
constexpr size_t OFF_GMM = OFF_GA + 131072;
constexpr size_t OFF_GWI = OFF_GMM + 131072;
constexpr size_t OFF_GEM = OFF_GWI + 131072;
constexpr size_t OFF_GWK = OFF_GEM + 131072;
constexpr size_t OFF_GDEC = OFF_GWK + 131072;
constexpr size_t OFF_NLOC = OFF_GDEC + 1024;
constexpr size_t OFF_WTIN = OFF_NLOC + 262144;
constexpr size_t OFF_WTPM = OFF_WTIN + (size_t)2 * NPK * 1024 * 2;
constexpr size_t OFF_WTPA = OFF_WTPM + (size_t)2 * 1024 * 2048 * 2;
constexpr size_t OFF_WTOUT = OFF_WTPA + (size_t)2 * 1024 * 1024 * 2;
constexpr size_t OFF_H = OFF_WTOUT + (size_t)2 * 1024 * 1024 * 2;
constexpr size_t OFF_NAT = OFF_H + (size_t)TOK * 1024 * 2;
constexpr size_t OFF_VMT = OFF_NAT + (size_t)TOK * NATW * 2;
constexpr size_t OFF_VAT = OFF_VMT + (size_t)2 * 2048 * 4096 * 2;
constexpr size_t OFF_Q = OFF_VAT + (size_t)2 * 1024 * 4096 * 2;
constexpr size_t OFF_KN = OFF_Q + (size_t)TOK * 1024 * 2;
constexpr size_t OFF_KT = OFF_KN + (size_t)TOK * 1024 * 2;
constexpr size_t OFF_CST = OFF_KT + (size_t)TOK * 1024 * 2;
constexpr size_t OFF_HM = OFF_CST + (size_t)8 * 32 * 512 * 256 * 2;
constexpr size_t OFF_HA = OFF_HM + (size_t)TOK * 2048 * 2;
constexpr size_t OFF_RS = OFF_HA + (size_t)TOK * 1024 * 2;
constexpr size_t WS_END = OFF_RS + (size_t)TOK * 4 * 4;

struct Params {
  const float *x, *c, *norm_g, *w_ada, *b_ada, *w_in, *b_if, *conv_w, *conv_b, *mnorm_g, *w_proj_m, *lam_q1, *lam_k1, *lam_q2, *lam_k2, *anorm_g, *w_proj_a, *w_out, *rel_bias, *final_g;
  float* out;
  unsigned char* ws;
};

DI int get_tid() { int t = (int)__builtin_amdgcn_workitem_id_x(); asm volatile("" : "+v"(t)); return t; }
DI unsigned short f2bf(float x) { return __builtin_bit_cast(unsigned short, (__bf16)x); }
typedef __bf16 hbf2 __attribute__((ext_vector_type(2)));
typedef float f32x2 __attribute__((ext_vector_type(2)));
DI unsigned pack2(float a, float b) { f32x2 v = {a, b}; hbf2 r = __builtin_convertvector(v, hbf2); return __builtin_bit_cast(unsigned, r); }
DI float bflo(unsigned v) { return __uint_as_float(v << 16); }
DI float bfhi(unsigned v) { return __uint_as_float(v & 0xffff0000u); }
DI float sigmoidf_(float x) { return 1.0f / (1.0f + __expf(-x)); }
DI float siluf_(float x) { return x / (1.0f + __expf(-x)); }
DI float wave_sum(float v) {
#pragma unroll
  for (int o = 32; o > 0; o >>= 1) v += __shfl_xor(v, o);
  return v;
}

constexpr int LDT = 72;
constexpr int CORE_SM = 2 * 128 * LDT;
struct NoHook { DI void operator()(int) const {} };
template <bool A_LDS, bool DB, class Hook = NoHook>
DI void gemm_core(const bf16_t* __restrict__ A, int lda, const bf16_t* __restrict__ B, int ldb, int K, f32x16 (&acc)[2][2], bf16_t* sm,
                  const bf16_t* aL, int ldaL, Hook hook = Hook()) {
  const int tid = get_tid(), lane = tid & 63, w = tid >> 6, wm = w >> 1, wn = w & 1, r = lane & 31, h = lane >> 5;
  const int lr = tid >> 3, lc = (tid & 7) * 8;
  u32x4 ra[4], rb[4];
  const int nk = K >> 6;
#pragma unroll
  for (int p = 0; p < 4; ++p) {
    if (!A_LDS) ra[p] = *(const u32x4*)(A + (size_t)(lr + 32 * p) * lda + lc);
    rb[p] = *(const u32x4*)(B + (size_t)(lr + 32 * p) * ldb + lc);
  }
  if (DB) {
    __syncthreads();
#pragma unroll
    for (int p = 0; p < 4; ++p) {
      if (!A_LDS) *(u32x4*)(sm + (lr + 32 * p) * LDT + lc) = ra[p];
      *(u32x4*)(sm + 128 * LDT + (lr + 32 * p) * LDT + lc) = rb[p];
    }
    if (nk > 1) {
#pragma unroll
      for (int p = 0; p < 4; ++p) {
        if (!A_LDS) ra[p] = *(const u32x4*)(A + (size_t)(lr + 32 * p) * lda + 64 + lc);
        rb[p] = *(const u32x4*)(B + (size_t)(lr + 32 * p) * ldb + 64 + lc);
      }
    }
    __syncthreads();
  }
#pragma unroll 1
  for (int kt = 0; kt < nk; ++kt) {
    hook(kt);
    bf16_t* As;
    if (DB) {
      As = sm + (kt & 1) * CORE_SM;
      bf16_t* Nx = sm + ((kt + 1) & 1) * CORE_SM;
      if (kt + 1 < nk) {
#pragma unroll
        for (int p = 0; p < 4; ++p) {
          if (!A_LDS) *(u32x4*)(Nx + (lr + 32 * p) * LDT + lc) = ra[p];
          *(u32x4*)(Nx + 128 * LDT + (lr + 32 * p) * LDT + lc) = rb[p];
        }
      }
      if (kt + 2 < nk) {
        const int ko = (kt + 2) * 64 + lc;
#pragma unroll
        for (int p = 0; p < 4; ++p) {
          if (!A_LDS) ra[p] = *(const u32x4*)(A + (size_t)(lr + 32 * p) * lda + ko);
          rb[p] = *(const u32x4*)(B + (size_t)(lr + 32 * p) * ldb + ko);
        }
      }
    } else {
      As = sm;
      __syncthreads();
#pragma unroll
      for (int p = 0; p < 4; ++p) {
        if (!A_LDS) *(u32x4*)(As + (lr + 32 * p) * LDT + lc) = ra[p];
        *(u32x4*)(As + 128 * LDT + (lr + 32 * p) * LDT + lc) = rb[p];
      }
      __syncthreads();
      if (kt + 1 < nk) {
        const int ko = (kt + 1) * 64 + lc;
#pragma unroll
        for (int p = 0; p < 4; ++p) {
          if (!A_LDS) ra[p] = *(const u32x4*)(A + (size_t)(lr + 32 * p) * lda + ko);
          rb[p] = *(const u32x4*)(B + (size_t)(lr + 32 * p) * ldb + ko);
        }
      }
    }
    const bf16_t* Bs = As + 128 * LDT;
    __builtin_amdgcn_s_setprio(2);
#pragma unroll
    for (int kk = 0; kk < 4; ++kk) {
      bf16x8 af[2], bfr[2];
#pragma unroll
      for (int i = 0; i < 2; ++i) {
        if (A_LDS) af[i] = *(const bf16x8*)(aL + (64 * wm + 32 * i + r) * ldaL + kt * 64 + kk * 16 + 8 * h);
        else af[i] = *(const bf16x8*)(As + (64 * wm + 32 * i + r) * LDT + kk * 16 + 8 * h);
      }
#pragma unroll
      for (int j = 0; j < 2; ++j) bfr[j] = *(const bf16x8*)(Bs + (64 * wn + 32 * j + r) * LDT + kk * 16 + 8 * h);
#pragma unroll
      for (int i = 0; i < 2; ++i)
#pragma unroll
        for (int j = 0; j < 2; ++j) acc[i][j] = MFMA32(bfr[j], af[i], acc[i][j]);
    }
#ifdef SGB
    __builtin_amdgcn_sched_group_barrier(0x100, 4, 0);
#pragma unroll
    for (int q = 0; q < 12; ++q) { __builtin_amdgcn_sched_group_barrier(0x008, 1, 0); __builtin_amdgcn_sched_group_barrier(0x100, 1, 0); }
    __builtin_amdgcn_sched_group_barrier(0x008, 4, 0);
#endif
    __builtin_amdgcn_s_setprio(0);
    if (DB) __syncthreads();
  }
}

DI void acc_zero(f32x16 (&acc)[2][2]) {
#pragma unroll
  for (int i = 0; i < 2; ++i)
#pragma unroll
    for (int j = 0; j < 2; ++j)
#pragma unroll
      for (int e = 0; e < 16; ++e) acc[i][j][e] = 0.f;
}

template <class F>
DI void for_quads(f32x16 (&acc)[2][2], F f) {
  const int lane = get_tid() & 63, w = get_tid() >> 6, wm = w >> 1, wn = w & 1, r = lane & 31, h = lane >> 5;
#pragma unroll
  for (int i = 0; i < 2; ++i)
#pragma unroll
    for (int j = 0; j < 2; ++j)
#pragma unroll
      for (int g = 0; g < 4; ++g) {
        float v0 = acc[i][j][4 * g], v1 = acc[i][j][4 * g + 1], v2 = acc[i][j][4 * g + 2], v3 = acc[i][j][4 * g + 3];
        f(64 * wm + 32 * i + r, 64 * wn + 32 * j + 8 * g + 4 * h, i, v0, v1, v2, v3);
        acc[i][j][4 * g] = v0; acc[i][j][4 * g + 1] = v1; acc[i][j][4 * g + 2] = v2; acc[i][j][4 * g + 3] = v3;
      }
}

DI void store_acc_bf16x8(f32x16 (&acc)[2][2], bf16_t* dst, size_t ld) {
  const int lane_ = get_tid() & 63, w_ = get_tid() >> 6, wm_ = w_ >> 1, wn_ = w_ & 1, r_ = lane_ & 31, h_ = lane_ >> 5;
#pragma unroll
  for (int i = 0; i < 2; ++i)
#pragma unroll
    for (int j = 0; j < 2; ++j)
#pragma unroll
      for (int gp = 0; gp < 2; ++gp) {
        const int g0 = 2 * gp, g1 = 2 * gp + 1;
        const unsigned a0 = pack2(acc[i][j][4 * g0], acc[i][j][4 * g0 + 1]), a1 = pack2(acc[i][j][4 * g0 + 2], acc[i][j][4 * g0 + 3]);
        const unsigned b0 = pack2(acc[i][j][4 * g1], acc[i][j][4 * g1 + 1]), b1 = pack2(acc[i][j][4 * g1 + 2], acc[i][j][4 * g1 + 3]);
        auto ra = __builtin_amdgcn_permlane32_swap(a0, b0, false, false);
        auto rb = __builtin_amdgcn_permlane32_swap(a1, b1, false, false);
        u32x4 o; o[0] = ra[0]; o[1] = rb[0]; o[2] = ra[1]; o[3] = rb[1];
        *(u32x4*)(dst + (size_t)(64 * wm_ + 32 * i + r_) * ld + 64 * wn_ + 32 * j + 8 * (2 * gp + h_)) = o;
      }
}

DI void transpose_tile(const float* __restrict__ src, int ldsrc, int srccol0, bf16_t* __restrict__ dst, int lddst, int dstrow0, int k0, float* smf) {
  const int tid = get_tid();
  __syncthreads();
#pragma unroll 4
  for (int i = 0; i < 16; ++i) { const int k = i * 4 + (tid >> 6), n = tid & 63; smf[k * 65 + n] = src[(size_t)(k0 + k) * ldsrc + srccol0 + n]; }
  __syncthreads();
#pragma unroll 4
  for (int i = 0; i < 16; ++i) { const int n = i * 4 + (tid >> 6), k = tid & 63; dst[(size_t)(dstrow0 + n) * lddst + k0 + k] = f2bf(smf[k * 65 + n]); }
}

DI void phase0(const Params& p, float* smf) {
  const int tid = get_tid();
  unsigned char* ws = p.ws;
  const int NT_IN = 16 * 224, NT_PM = 32 * 16, NT_PA = 16 * 16, NT_OUT = 16 * 16, PER_L = NT_IN + NT_PM + NT_PA + NT_OUT;
  const int N_TR = 2 * PER_L, N_MOD = 192, N_WG = 2;
  for (int it = blockIdx.x; it < N_TR + N_MOD + N_WG; it += gridDim.x) {
    if (it < N_TR) {
      const int l = it / PER_L;
      int q = it % PER_L;
      if (q < NT_IN) {
        const int nt = q / 16, kt = q % 16, n0 = nt * 64, sc = n0 < 8192 ? n0 : n0 + 8;
        transpose_tile(p.w_in + (size_t)l * 1024 * NIN, NIN, sc, (bf16_t*)(ws + OFF_WTIN) + (size_t)l * NPK * 1024, 1024, n0, kt * 64, smf);
      } else if ((q -= NT_IN) < NT_PM) {
        const int nt = q / 32, kt = q % 32;
        transpose_tile(p.w_proj_m + (size_t)l * 2048 * 1024, 1024, nt * 64, (bf16_t*)(ws + OFF_WTPM) + (size_t)l * 1024 * 2048, 2048, nt * 64, kt * 64, smf);
      } else if ((q -= NT_PM) < NT_PA) {
        const int nt = q / 16, kt = q % 16;
        transpose_tile(p.w_proj_a + (size_t)l * 1024 * 1024, 1024, nt * 64, (bf16_t*)(ws + OFF_WTPA) + (size_t)l * 1024 * 1024, 1024, nt * 64, kt * 64, smf);
      } else {
        q -= NT_PA;
        const int nt = q / 16, kt = q % 16;
        transpose_tile(p.w_out + (size_t)l * 1024 * 1024, 1024, nt * 64, (bf16_t*)(ws + OFF_WTOUT) + (size_t)l * 1024 * 1024, 1024, nt * 64, kt * 64, smf);
      }
    } else if (it < N_TR + N_MOD) {
      const int q = it - N_TR, l = q / 96, ch = q % 96;
      float* cact = smf;
      float* part = smf + 8192;
      __syncthreads();
      for (int i = tid; i < 8192; i += 256) cact[i] = siluf_(p.c[i]);
      __syncthreads();
      const int col = ch * 32 + (tid & 31), kg = tid >> 5;
      float a[8];
#pragma unroll
      for (int b = 0; b < 8; ++b) a[b] = 0.f;
      const float* wp = p.w_ada + (size_t)l * 1024 * 3072 + col;
      for (int k = kg * 128; k < kg * 128 + 128; ++k) {
        const float wv = wp[(size_t)k * 3072];
#pragma unroll
        for (int b = 0; b < 8; ++b) a[b] += cact[b * 1024 + k] * wv;
      }
#pragma unroll
      for (int b = 0; b < 8; ++b) part[(kg * 8 + b) * 32 + (tid & 31)] = a[b];
      __syncthreads();
      {
        const int b = tid >> 5, cc = tid & 31;
        float s = 0.f;
#pragma unroll
        for (int g = 0; g < 8; ++g) s += part[(g * 8 + b) * 32 + cc];
        const int colo = ch * 32 + cc;
        ((float*)(ws + OFF_MOD))[(l * 8 + b) * 3072 + colo] = s + p.b_ada[l * 3072 + colo];
      }
    } else {
      const int l = it - N_TR - N_MOD;
      float* wg = (float*)(ws + OFF_WG) + l * 8192;
      for (int i = tid; i < 8192; i += 256) wg[i] = p.w_in[(size_t)l * 1024 * NIN + (size_t)(i >> 3) * NIN + 8192 + (i & 7)];
    }
  }
}

DI void norm_rows(const Params& p, int l, int grp, int item_begin, int item_stride) {
  const int tid = get_tid(), lane = tid & 63, w = tid >> 6;
  unsigned char* ws = p.ws;
  const float* xin = (l == 0) ? p.x : p.out;
  const float* mod = (const float*)(ws + OFF_MOD);
  const float* wg = (const float*)(ws + OFF_WG) + l * 8192;
  bf16_t* H = (bf16_t*)(ws + OFF_H);
  float* GI = (float*)(ws + OFF_GI);
  float* GF = (float*)(ws + OFF_GF);
  for (int it = item_begin; it < TOK / 4; it += item_stride) {
    const int tl = it * 4 + w, bl = tl >> 12, t = tl & 4095, bg = grp * 2 + bl;
    const float* xr = xin + ((size_t)grp * TOK + tl) * DM;
    f32x4 xv[4];
    float ss = 0.f;
#pragma unroll
    for (int i = 0; i < 4; ++i) { xv[i] = *(const f32x4*)(xr + 256 * i + 4 * lane); ss += xv[i][0] * xv[i][0] + xv[i][1] * xv[i][1] + xv[i][2] * xv[i][2] + xv[i][3] * xv[i][3]; }
    ss = wave_sum(ss);
    const float rstd = rsqrtf(ss * (1.0f / DM) + EPS);
    float ga[8];
#pragma unroll
    for (int j = 0; j < 8; ++j) ga[j] = 0.f;
    const float* mrow = mod + (l * 8 + bg) * 3072;
#pragma unroll
    for (int i = 0; i < 4; ++i) {
      const int col = 256 * i + 4 * lane;
      const f32x4 g = *(const f32x4*)(p.norm_g + l * DM + col), sh = *(const f32x4*)(mrow + col), sc = *(const f32x4*)(mrow + 1024 + col);
      float hv[4];
#pragma unroll
      for (int e = 0; e < 4; ++e) hv[e] = xv[i][e] * rstd * g[e] * (1.0f + sc[e]) + sh[e];
      u32x2 o; o[0] = pack2(hv[0], hv[1]); o[1] = pack2(hv[2], hv[3]);
      *(u32x2*)(H + (size_t)tl * DM + col) = o;
#pragma unroll
      for (int e = 0; e < 4; ++e) {
        const f32x4 w0 = *(const f32x4*)(wg + (col + e) * 8), w1 = *(const f32x4*)(wg + (col + e) * 8 + 4);
#pragma unroll
        for (int j = 0; j < 4; ++j) { ga[j] += hv[e] * w0[j]; ga[4 + j] += hv[e] * w1[j]; }
      }
    }
#pragma unroll
    for (int j = 0; j < 8; ++j) ga[j] = wave_sum(ga[j]);
    if (lane < 8) {
      float v = ga[0];
#pragma unroll
      for (int j = 1; j < 8; ++j) v = (lane == j) ? ga[j] : v;
      v += p.b_if[l * 8 + lane];
      const int hh = lane & 3;
      float* dst = (lane < 4) ? GI : GF;
      dst[(bl * 4 + hh) * 4096 + t] = v;
    }
  }
}

DI void gate_scan(const Params& p, int bh, float* sf) {
  const int tid = get_tid(), g = tid >> 3, j = tid & 7, t0 = tid * 16;
  unsigned char* ws = p.ws;
  const float* GI = (const float*)(ws + OFF_GI) + bh * 4096 + t0;
  const float* GF = (const float*)(ws + OFF_GF) + bh * 4096 + t0;
  float* s_cm = sf; float* s_bl = sf + 32; float* s_mp = sf + 64; float* s_mml = sf + 96;
  float a[16], b[16], cm[16];
#pragma unroll
  for (int q = 0; q < 4; ++q) {
    const f32x4 fv = *(const f32x4*)(GF + 4 * q), iv = *(const f32x4*)(GI + 4 * q);
#pragma unroll
    for (int e = 0; e < 4; ++e) { const float f = fv[e]; b[4 * q + e] = fminf(f, 0.f) - log1pf(__expf(-fabsf(f))); a[4 * q + e] = iv[e]; }
  }
  float s = 0.f;
#pragma unroll
  for (int k = 0; k < 16; ++k) { s += b[k]; b[k] = s; }
  float inc = s;
#pragma unroll
  for (int o = 1; o < 8; o <<= 1) { const float v = __shfl_up(inc, o, 8); if (j >= o) inc += v; }
  const float excl = inc - s;
  float m = -INFINITY;
#pragma unroll
  for (int k = 0; k < 16; ++k) { b[k] += excl; a[k] -= b[k]; m = fmaxf(m, a[k]); cm[k] = m; }
  float inc2 = m;
#pragma unroll
  for (int o = 1; o < 8; o <<= 1) { const float v = __shfl_up(inc2, o, 8); if (j >= o) inc2 = fmaxf(inc2, v); }
  float exm = __shfl_up(inc2, 1, 8);
  if (j == 0) exm = -INFINITY;
#pragma unroll
  for (int k = 0; k < 16; ++k) cm[k] = fmaxf(cm[k], exm);
  __syncthreads();
  if (j == 7) { s_cm[g] = cm[15]; s_bl[g] = b[15]; }
  __syncthreads();
  if (tid == 0) {
    float mp = 0.f;
    float* GDEC = (float*)(ws + OFF_GDEC) + bh * 32;
    for (int c = 0; c < 32; ++c) {
      s_mp[c] = mp;
      const float mml = fmaxf(mp, s_cm[c]);
      s_mml[c] = mml;
      GDEC[c] = __expf(mp - mml);
      mp = s_bl[c] + mml;
    }
  }
  __syncthreads();
  const float mp = s_mp[g], mml = s_mml[g];
  float* GA = (float*)(ws + OFF_GA) + bh * 4096 + t0;
  float* GMM = (float*)(ws + OFF_GMM) + bh * 4096 + t0;
  float* GWI = (float*)(ws + OFF_GWI) + bh * 4096 + t0;
  float* GEM = (float*)(ws + OFF_GEM) + bh * 4096 + t0;
  float* GWK = (float*)(ws + OFF_GWK) + bh * 4096 + t0;
#pragma unroll
  for (int q = 0; q < 4; ++q) {
    f32x4 va, vmm, vwi, vem, vwk;
#pragma unroll
    for (int e = 0; e < 4; ++e) {
      const int k = 4 * q + e;
      const float mm = fmaxf(mp, cm[k]);
      va[e] = a[k]; vmm[e] = mm; vwi[e] = __expf(mp - mm); vem[e] = __expf(-(b[k] + mm)); vwk[e] = __expf(a[k] - mml);
    }
    *(f32x4*)(GA + 4 * q) = va; *(f32x4*)(GMM + 4 * q) = vmm; *(f32x4*)(GWI + 4 * q) = vwi; *(f32x4*)(GEM + 4 * q) = vem; *(f32x4*)(GWK + 4 * q) = vwk;
  }
}

DI void inproj_tile(const Params& p, int l, int mt, int nt, bf16_t* sm) {
  unsigned char* ws = p.ws;
  const bf16_t* H = (const bf16_t*)(ws + OFF_H) + (size_t)mt * 128 * DM;
  const bf16_t* W = (const bf16_t*)(ws + OFF_WTIN) + ((size_t)l * NPK + (size_t)nt * 128) * 1024;
  const int n0 = nt * 128;
  bool tr = false; int dcol = 0; bf16_t* tb = nullptr;
  if (n0 < 2048) dcol = n0;
  else if (n0 < 4096) { tr = true; tb = (bf16_t*)(ws + OFF_VMT) + ((size_t)((mt >> 5) * 2048 + (n0 - 2048))) * 4096 + (mt & 31) * 128; }
  else if (n0 < 10240) dcol = n0 - 2048;
  else if (n0 < 11264) { tr = true; tb = (bf16_t*)(ws + OFF_VAT) + ((size_t)((mt >> 5) * 1024 + (n0 - 10240))) * 4096 + (mt & 31) * 128; }
  else dcol = n0 - 3072;
  f32x16 acc[2][2];
  acc_zero(acc);
  if (!tr) {
    gemm_core<false, true>(H, DM, W, 1024, 1024, acc, sm, nullptr, 0);
    bf16_t* dst = (bf16_t*)(ws + OFF_NAT) + (size_t)mt * 128 * NATW + dcol;
    {
      bf16_t* Ct = sm;
      for_quads(acc, [&](int ar, int br, int ii, float v0, float v1, float v2, float v3) {
        u32x2 o; o[0] = pack2(v0, v1); o[1] = pack2(v2, v3);
        *(u32x2*)(Ct + ar * 136 + br) = o;
      });
      __syncthreads();
      const int tid_ = get_tid();
#pragma unroll
      for (int q = 0; q < 8; ++q) {
        const int id = tid_ + 256 * q, row = id >> 4, ch = id & 15;
        *(u32x4*)(dst + (size_t)row * NATW + ch * 8) = *(const u32x4*)(Ct + row * 136 + ch * 8);
      }
    }
  } else {
    gemm_core<false, true>(W, 1024, H, DM, 1024, acc, sm, nullptr, 0);
    store_acc_bf16x8(acc, tb, 4096);
  }
}

DI void conv_item(const Params& p, int l, int idx, float* smf) {
  const int tid = get_tid(), cg = tid & 31, tg = tid >> 5;
  unsigned char* ws = p.ws;
  const int which = idx & 1, c = (idx >> 1) & 31, bh = idx >> 6, bl = bh >> 2, h = bh & 3;
  const int ch0 = which * 1024 + h * 256 + 8 * cg;
  float w[4][8], bias[8];
#pragma unroll
  for (int j = 0; j < 4; ++j) {
    const f32x4 a0 = *(const f32x4*)(p.conv_w + (l * 4 + j) * 2048 + ch0), a1 = *(const f32x4*)(p.conv_w + (l * 4 + j) * 2048 + ch0 + 4);
#pragma unroll
    for (int e = 0; e < 4; ++e) { w[j][e] = a0[e]; w[j][4 + e] = a1[e]; }
  }
  {
    const f32x4 a0 = *(const f32x4*)(p.conv_b + l * 2048 + ch0), a1 = *(const f32x4*)(p.conv_b + l * 2048 + ch0 + 4);
#pragma unroll
    for (int e = 0; e < 4; ++e) { bias[e] = a0[e]; bias[4 + e] = a1[e]; }
  }
  const int ts = c * 128 + 16 * tg;
  const bf16_t* src = (const bf16_t*)(ws + OFF_NAT) + (size_t)bl * 4096 * NATW + (which ? C_KM : C_QM) + h * 256 + 8 * cg;
  u32x4 raw[19];
#pragma unroll
  for (int i = 0; i < 19; ++i) {
    const int t = ts - 3 + i;
    if (t >= 0) raw[i] = *(const u32x4*)(src + (size_t)t * NATW);
    else raw[i] = (u32x4){0u, 0u, 0u, 0u};
  }
  bf16_t* OUT = (bf16_t*)(ws + (which ? OFF_KN : OFF_Q)) + (size_t)bl * 4096 * 1024 + h * 256 + 8 * cg;
  bf16_t* KT = (bf16_t*)(ws + OFF_KT) + (size_t)(bh * 256 + 8 * cg) * 4096 + ts;
  const float* GWK = (const float*)(ws + OFF_GWK) + bh * 4096 + ts;
  float nacc[8];
#pragma unroll
  for (int e = 0; e < 8; ++e) nacc[e] = 0.f;
  const float osc = which ? 0.0625f : 1.0f;
#pragma unroll
  for (int half = 0; half < 2; ++half) {
    float ks[8][8];
    f32x4 wk0, wk1;
    if (which) { wk0 = *(const f32x4*)(GWK + 8 * half); wk1 = *(const f32x4*)(GWK + 8 * half + 4); }
#pragma unroll
    for (int tt = 0; tt < 8; ++tt) {
      const int i = 8 * half + tt;
      float y[8];
#pragma unroll
      for (int q = 0; q < 4; ++q) {
        const unsigned r0 = raw[i][q], r1 = raw[i + 1][q], r2 = raw[i + 2][q], r3 = raw[i + 3][q];
        y[2 * q] = w[3][2 * q] * bflo(r3) + bias[2 * q] + w[0][2 * q] * bflo(r0) + w[1][2 * q] * bflo(r1) + w[2][2 * q] * bflo(r2);
        y[2 * q + 1] = w[3][2 * q + 1] * bfhi(r3) + bias[2 * q + 1] + w[0][2 * q + 1] * bfhi(r0) + w[1][2 * q + 1] * bfhi(r1) + w[2][2 * q + 1] * bfhi(r2);
      }
#pragma unroll
      for (int e = 0; e < 8; ++e) y[e] = siluf_(y[e]) * osc;
      u32x4 o; o[0] = pack2(y[0], y[1]); o[1] = pack2(y[2], y[3]); o[2] = pack2(y[4], y[5]); o[3] = pack2(y[6], y[7]);
      *(u32x4*)(OUT + (size_t)(ts + i) * 1024) = o;
      if (which) {
        const float wkv = tt < 4 ? wk0[tt & 3] : wk1[tt & 3];
#pragma unroll
        for (int e = 0; e < 8; ++e) { ks[tt][e] = y[e] * wkv; nacc[e] += ks[tt][e]; }
      }
    }
    if (which) {
#pragma unroll
      for (int e = 0; e < 8; ++e) {
        u32x4 o; o[0] = pack2(ks[0][e], ks[1][e]); o[1] = pack2(ks[2][e], ks[3][e]); o[2] = pack2(ks[4][e], ks[5][e]); o[3] = pack2(ks[6][e], ks[7][e]);
        *(u32x4*)(KT + (size_t)e * 4096 + 8 * half) = o;
      }
    }
  }
  if (which) {
    __syncthreads();
#pragma unroll
    for (int e = 0; e < 8; ++e) smf[tg * 256 + 8 * cg + e] = nacc[e];
    __syncthreads();
    float s = 0.f;
#pragma unroll
    for (int g = 0; g < 8; ++g) s += smf[g * 256 + tid];
    ((float*)(ws + OFF_NLOC))[(bh * 32 + c) * 256 + tid] = s;
  }
}

DI void state_chain(const Params& p, int idx, int rd, bf16_t* sm) {
  unsigned char* ws = p.ws;
  const int bh = idx >> 3, i2 = (idx >> 2) & 1, j4 = idx & 3, bl = bh >> 2, h = bh & 3;
  const bf16_t* VT = (const bf16_t*)(ws + OFF_VMT) + (size_t)(bl * 2048 + h * 512 + j4 * 128) * 4096;
  const bf16_t* KT = (const bf16_t*)(ws + OFF_KT) + (size_t)(bh * 256 + i2 * 128) * 4096;
  const float* GDEC = (const float*)(ws + OFF_GDEC) + bh * 32;
  bf16_t* dst0 = (bf16_t*)(ws + OFF_CST) + ((size_t)(bh * 32) * 512 + j4 * 128) * 256 + i2 * 128;
  f32x16 acc[2][2];
  acc_zero(acc);
  auto snap = [&](int c) {
    bf16_t* dst = dst0 + (size_t)c * 512 * 256;
    store_acc_bf16x8(acc, dst, 256);
  };
  gemm_core<false, true>(VT, 4096, KT, 4096, 31 * 128, acc, sm, nullptr, 0, [&](int kt) {
    if ((kt & 1) == 0) {
      const int c = kt >> 1;
      snap(c);
      const float dec = GDEC[c];
#pragma unroll
      for (int i = 0; i < 2; ++i)
#pragma unroll
        for (int j = 0; j < 2; ++j) acc[i][j] *= dec;
    }
  });
  snap(31);
  asm volatile("s_waitcnt vmcnt(0)" ::: "memory");
  __syncthreads();
  if (get_tid() == 0) {
    __builtin_amdgcn_fence(__ATOMIC_RELEASE, "agent");
    asm volatile("s_waitcnt vmcnt(0)" ::: "memory");
    __hip_atomic_fetch_add((unsigned*)(ws + OFF_CNT) + 256 + rd * 8 + bh, 1u, __ATOMIC_RELAXED, __HIP_MEMORY_SCOPE_AGENT);
  }
}

constexpr int LDP = 136;
DI void mlstm_out_item(const Params& p, int l, int idx, int rd, bf16_t* sm) {
  const int tid = get_tid(), lane = tid & 63, h5 = lane >> 5;
  unsigned char* ws = p.ws;
  const int bh = idx >> 5, c = idx & 31, bl = bh >> 2, h = bh & 3;
  const size_t tok0 = (size_t)bl * 4096 + c * 128;
  bf16_t* Ps = sm + CORE_SM;
  float* vec = (float*)(sm + CORE_SM + 128 * LDP);
  float *sa = vec, *smm = vec + 128, *swi = vec + 256, *sden = vec + 384, *ssq = vec + 512, *sn = vec + 640, *sgem = vec + 896;
  const bf16_t* Q = (const bf16_t*)(ws + OFF_Q) + tok0 * 1024 + h * 256;
  const bf16_t* KN = (const bf16_t*)(ws + OFF_KN) + tok0 * 1024 + h * 256;
  const float* GDEC = (const float*)(ws + OFF_GDEC) + bh * 32;
  const float* GEM = (const float*)(ws + OFF_GEM) + bh * 4096 + c * 128;
  if (tid == 0) {
    unsigned* dn = (unsigned*)(ws + OFF_CNT) + 256 + rd * 8 + bh;
    unsigned sp = 0;
    while (__hip_atomic_load(dn, __ATOMIC_RELAXED, __HIP_MEMORY_SCOPE_AGENT) < 8u) { __builtin_amdgcn_s_sleep(8); if (++sp > (1u << 22)) break; }
    __builtin_amdgcn_fence(__ATOMIC_ACQUIRE, "agent");
    asm volatile("s_waitcnt vmcnt(0)" ::: "memory");
  }
  __syncthreads();
  if (tid < 128) {
    sa[tid] = ((const float*)(ws + OFF_GA))[bh * 4096 + c * 128 + tid];
    smm[tid] = ((const float*)(ws + OFF_GMM))[bh * 4096 + c * 128 + tid];
    swi[tid] = ((const float*)(ws + OFF_GWI))[bh * 4096 + c * 128 + tid];
    sden[tid] = 0.f;
    ssq[tid] = 0.f;
    sgem[tid] = GEM[tid];
  }
  {
    float n = 0.f;
    const float* NL = (const float*)(ws + OFF_NLOC) + (size_t)bh * 32 * 256 + tid;
#pragma unroll 1
    for (int c0 = 0; c0 < c; c0 += 8) {
      float nv[8], dv[8];
#pragma unroll
      for (int q = 0; q < 8; ++q) { const int cc = c0 + q < c ? c0 + q : c - 1; nv[q] = NL[cc * 256]; dv[q] = GDEC[cc]; }
#pragma unroll
      for (int q = 0; q < 8; ++q) if (c0 + q < c) n = n * dv[q] + nv[q];
    }
    sn[tid] = n;
  }
  __syncthreads();
  {
    const int t = tid >> 1, half = tid & 1;
    const bf16_t* qr = Q + (size_t)t * 1024 + half * 128;
    float d = 0.f;
#pragma unroll 4
    for (int k = 0; k < 128; k += 8) {
      const u32x4 v = *(const u32x4*)(qr + k);
      const float* nn = sn + half * 128 + k;
      d += bflo(v[0]) * nn[0] + bfhi(v[0]) * nn[1] + bflo(v[1]) * nn[2] + bfhi(v[1]) * nn[3] + bflo(v[2]) * nn[4] + bfhi(v[2]) * nn[5] + bflo(v[3]) * nn[6] + bfhi(v[3]) * nn[7];
    }
    atomicAdd(&sden[t], swi[t] * d);
  }
  f32x16 acc[2][2];
  acc_zero(acc);
  gemm_core<false, false>(Q, 1024, KN, 1024, 256, acc, sm, nullptr, 0);
  {
    float psum[2] = {0.f, 0.f};
    const int w = tid >> 6, wm = w >> 1, r = lane & 31;
    for_quads(acc, [&](int ar, int br, int ii, float v0, float v1, float v2, float v3) {
      const float mt = smm[ar];
      const f32x4 av = *(const f32x4*)(sa + br);
      const float p0 = (br + 0 <= ar) ? v0 * __expf(av[0] - mt) : 0.f;
      const float p1 = (br + 1 <= ar) ? v1 * __expf(av[1] - mt) : 0.f;
      const float p2 = (br + 2 <= ar) ? v2 * __expf(av[2] - mt) : 0.f;
      const float p3 = (br + 3 <= ar) ? v3 * __expf(av[3] - mt) : 0.f;
      psum[ii] += (p0 + p1) + (p2 + p3);
      u32x2 o; o[0] = pack2(p0, p1); o[1] = pack2(p2, p3);
      *(u32x2*)(Ps + ar * LDP + br) = o;
    });
#pragma unroll
    for (int i = 0; i < 2; ++i) {
      float s = psum[i];
      s += __shfl_xor(s, 32);
      if (h5 == 0) atomicAdd(&sden[64 * wm + 32 * i + r], s);
    }
  }
  __syncthreads();
  const bf16_t* OMp = (const bf16_t*)(ws + OFF_NAT) + tok0 * NATW + C_OM + h * 512;
  const bf16_t* ZMp = (const bf16_t*)(ws + OFF_NAT) + tok0 * NATW + C_ZM + h * 512;
  bf16_t* HMp = (bf16_t*)(ws + OFF_HM) + tok0 * 2048 + h * 512;
  bf16_t* Ht = sm;
  const int row = tid >> 1, hf = tid & 1;
  float sq = 0.f;
#pragma unroll 1
  for (int j4 = 0; j4 < 4; ++j4) {
    acc_zero(acc);
    if (c > 0) {
      gemm_core<false, false>(Q, 1024, (const bf16_t*)(ws + OFF_CST) + ((size_t)(bh * 32 + c) * 512 + j4 * 128) * 256, 256, 256, acc, sm, nullptr, 0);
      for_quads(acc, [&](int ar, int br, int ii, float& v0, float& v1, float& v2, float& v3) { const float s = swi[ar]; v0 *= s; v1 *= s; v2 *= s; v3 *= s; });
    }
    gemm_core<true, false>(nullptr, 0, (const bf16_t*)(ws + OFF_VMT) + (size_t)(bl * 2048 + h * 512 + j4 * 128) * 4096 + c * 128, 4096, 128, acc, sm, Ps, LDP);
    __syncthreads();
    for_quads(acc, [&](int ar, int br, int ii, float v0, float v1, float v2, float v3) {
      const float den = 1.0f / fmaxf(fabsf(sden[ar]), sgem[ar]);
      u32x2 o; o[0] = pack2(v0 * den, v1 * den); o[1] = pack2(v2 * den, v3 * den);
      *(u32x2*)(Ht + ar * LDP + br) = o;
    });
    __syncthreads();
#pragma unroll
    for (int q = 0; q < 8; ++q) {
      const int dv0 = hf * 64 + q * 8;
      const u32x4 hv = *(const u32x4*)(Ht + row * LDP + dv0);
      const u32x4 ov = *(const u32x4*)(OMp + (size_t)row * NATW + j4 * 128 + dv0);
      const u32x4 zv = *(const u32x4*)(ZMp + (size_t)row * NATW + j4 * 128 + dv0);
      const f32x4 g0 = *(const f32x4*)(p.mnorm_g + l * 2048 + h * 512 + j4 * 128 + dv0), g1 = *(const f32x4*)(p.mnorm_g + l * 2048 + h * 512 + j4 * 128 + dv0 + 4);
      u32x4 o;
#pragma unroll
      for (int e = 0; e < 4; ++e) {
        const float x0 = bflo(hv[e]) * sigmoidf_(bflo(ov[e])), x1 = bfhi(hv[e]) * sigmoidf_(bfhi(ov[e]));
        sq += x0 * x0 + x1 * x1;
        const float ga = e < 2 ? g0[2 * e] : g1[2 * e - 4], gb = e < 2 ? g0[2 * e + 1] : g1[2 * e - 3];
        o[e] = pack2(x0 * ga * siluf_(bflo(zv[e])), x1 * gb * siluf_(bfhi(zv[e])));
      }
      *(u32x4*)(HMp + (size_t)row * 2048 + j4 * 128 + dv0) = o;
    }
  }
  sq += __shfl_xor(sq, 1);
  if (hf == 0) ((float*)(ws + OFF_RS))[(tok0 + row) * 4 + h] = rsqrtf(sq * (1.0f / 512.0f) + EPS);
}

#define MFMA16(a, b, c) __builtin_amdgcn_mfma_f32_16x16x32_bf16((a), (b), (c), 0, 0, 0)
DI void attn_item(const Params& p, int l, int bl, int hd, int qb, bf16_t* sm) {
  const int tid = get_tid(), lane = tid & 63, w = tid >> 6, r16 = lane & 15, q4 = lane >> 4;
  unsigned char* ws = p.ws;
  bf16_t* Ks = sm;
  bf16_t* Vs = sm + 2 * 64 * LDT;
  float* tb = (float*)(sm + 2 * 64 * LDT + 128 * LDT);
  const bf16_t* NAT = (const bf16_t*)(ws + OFF_NAT) + (size_t)bl * 4096 * NATW;
  const bf16_t* VT = (const bf16_t*)(ws + OFF_VAT) + (size_t)(bl * 1024 + hd * 128) * 4096;
  const int wu = __builtin_amdgcn_readfirstlane(w);
  const int Q0 = qb * 64, t0 = Q0 + 16 * wu, t = t0 + r16;
  float lam;
  {
    float s1 = 0.f, s2 = 0.f;
    for (int i = 0; i < 64; ++i) { s1 += p.lam_q1[l * 64 + i] * p.lam_k1[l * 64 + i]; s2 += p.lam_q2[l * 64 + i] * p.lam_k2[l * 64 + i]; }
    lam = __expf(s1) - __expf(s2) + (l == 0 ? 0.2f : 0.35550906f);
  }
  const float oml = (l == 0) ? 0.8f : 0.64449094f;
  __syncthreads();
  if (tid < 129) {
    int bucket;
    if (tid < 16) bucket = tid;
    else { const float v = logf((float)tid / 16.0f) / 2.0794415416798357f * 16.0f; bucket = 16 + (int)v; if (bucket > 31) bucket = 31; }
    tb[tid] = p.rel_bias[bucket * 8 + hd] * LOG2E;
  }
  bf16_t* Qs = sm + 2 * 64 * LDT + 128 * LDT + 512;
#pragma unroll
  for (int pp = 0; pp < 4; ++pp) {
    const int id = tid + 256 * pp, row = id >> 4, ch = id & 15;
    *(u32x4*)(Qs + row * LDP + ch * 8) = *(const u32x4*)(NAT + (size_t)(Q0 + row) * NATW + C_QA + hd * 128 + ch * 8);
  }
  f32x4 O[2][8];
#pragma unroll
  for (int m = 0; m < 2; ++m)
#pragma unroll
    for (int jd = 0; jd < 8; ++jd)
#pragma unroll
      for (int e = 0; e < 4; ++e) O[m][jd][e] = 0.f;
  float Mx[2] = {-INFINITY, -INFINITY}, Ls[2] = {0.f, 0.f};
  const int ntile = qb + 1;
  const float c1 = 0.125f * LOG2E;
  u32x4 rk[4], rv[4];
#pragma unroll
  for (int pp = 0; pp < 4; ++pp) {
    const int id = tid + 256 * pp;
    rk[pp] = *(const u32x4*)(NAT + (size_t)((id >> 3) & 63) * NATW + C_KA + hd * 128 + (id >> 9) * 64 + (id & 7) * 8);
    rv[pp] = *(const u32x4*)(VT + (size_t)(id >> 3) * 4096 + (id & 7) * 8);
  }
#pragma unroll 1
  for (int kt = 0; kt < ntile; ++kt) {
    const int s0 = kt * 64;
    __syncthreads();
#pragma unroll
    for (int pp = 0; pp < 4; ++pp) {
      const int id = tid + 256 * pp;
      *(u32x4*)(Ks + ((id >> 9) * 64 + ((id >> 3) & 63)) * LDT + (id & 7) * 8) = rk[pp];
      *(u32x4*)(Vs + (id >> 3) * LDT + (id & 7) * 8) = rv[pp];
    }
    __syncthreads();
    if (kt + 1 < ntile) {
#pragma unroll
      for (int pp = 0; pp < 4; ++pp) {
        const int id = tid + 256 * pp;
        rk[pp] = *(const u32x4*)(NAT + (size_t)(s0 + 64 + ((id >> 3) & 63)) * NATW + C_KA + hd * 128 + (id >> 9) * 64 + (id & 7) * 8);
        rv[pp] = *(const u32x4*)(VT + (size_t)(id >> 3) * 4096 + s0 + 64 + (id & 7) * 8);
      }
    }
    if (s0 <= t0 + 15) {
      const bool nearb = (s0 + 63 + 128 > t0);
      const float tb128 = tb[128];
      u32x4 pk[2][2];
#pragma unroll
      for (int m = 0; m < 2; ++m) {
        f32x4 sacc[4];
#pragma unroll
        for (int st = 0; st < 4; ++st) {
#pragma unroll
          for (int e = 0; e < 4; ++e) sacc[st][e] = 0.f;
#pragma unroll
          for (int kk = 0; kk < 2; ++kk) {
            const bf16x8 a = *(const bf16x8*)(Ks + (m * 64 + 16 * st + r16) * LDT + kk * 32 + 8 * q4);
            const bf16x8 qfr = *(const bf16x8*)(Qs + (16 * wu + r16) * LDP + m * 64 + kk * 32 + 8 * q4);
            sacc[st] = MFMA16(a, qfr, sacc[st]);
          }
        }
        float alpha, ps = 0.f;
        if (!nearb) {
          float mx = fmaxf(fmaxf(sacc[0][0], sacc[0][1]), fmaxf(sacc[0][2], sacc[0][3]));
#pragma unroll
          for (int st = 1; st < 4; ++st) mx = fmaxf(mx, fmaxf(fmaxf(sacc[st][0], sacc[st][1]), fmaxf(sacc[st][2], sacc[st][3])));
          float Mn = Mx[m];
          alpha = 1.0f;
          if (__builtin_amdgcn_ballot_w64(mx * c1 + tb128 - Mn > 8.0f) != 0ull) {
            mx = fmaxf(mx, __shfl_xor(mx, 16));
            mx = fmaxf(mx, __shfl_xor(mx, 32));
            Mn = fmaxf(Mn, mx * c1 + tb128); alpha = __builtin_amdgcn_exp2f(Mx[m] - Mn); Mx[m] = Mn;
          }
          const float off = tb128 - Mn;
#pragma unroll
          for (int st = 0; st < 4; ++st)
#pragma unroll
            for (int e = 0; e < 4; ++e) { const float pv = __builtin_amdgcn_exp2f(sacc[st][e] * c1 + off); sacc[st][e] = pv; ps += pv; }
        } else {
          float mx = -INFINITY;
#pragma unroll
          for (int st = 0; st < 4; ++st)
#pragma unroll
            for (int e = 0; e < 4; ++e) {
              const int s = s0 + 16 * st + 4 * q4 + e;
              const int rel = t - s;
              int ri = rel < 0 ? 0 : rel; ri = ri > 128 ? 128 : ri;
              float xv = sacc[st][e] * c1 + tb[ri];
              if (rel < 0) xv = -INFINITY;
              sacc[st][e] = xv;
              mx = fmaxf(mx, xv);
            }
          float Mn = Mx[m];
          alpha = 1.0f;
          if (__builtin_amdgcn_ballot_w64(mx - Mn > 8.0f) != 0ull) {
            mx = fmaxf(mx, __shfl_xor(mx, 16));
            mx = fmaxf(mx, __shfl_xor(mx, 32));
            Mn = fmaxf(Mn, mx); alpha = __builtin_amdgcn_exp2f(Mx[m] - Mn); Mx[m] = Mn;
          }
#pragma unroll
          for (int st = 0; st < 4; ++st)
#pragma unroll
            for (int e = 0; e < 4; ++e) { const float pv = __builtin_amdgcn_exp2f(sacc[st][e] - Mn); sacc[st][e] = pv; ps += pv; }
        }
        Ls[m] = Ls[m] * alpha + ps;
        if (__builtin_amdgcn_ballot_w64(alpha != 1.0f) != 0ull) {
#pragma unroll
          for (int jd = 0; jd < 8; ++jd) O[m][jd] *= alpha;
        }
#pragma unroll
        for (int u = 0; u < 2; ++u) {
          pk[m][u][0] = pack2(sacc[2 * u][0], sacc[2 * u][1]); pk[m][u][1] = pack2(sacc[2 * u][2], sacc[2 * u][3]);
          pk[m][u][2] = pack2(sacc[2 * u + 1][0], sacc[2 * u + 1][1]); pk[m][u][3] = pack2(sacc[2 * u + 1][2], sacc[2 * u + 1][3]);
        }
        __builtin_amdgcn_sched_barrier(0);
      }
#pragma unroll
      for (int u = 0; u < 2; ++u) {
        const bf16x8 pf0 = __builtin_bit_cast(bf16x8, pk[0][u]), pf1 = __builtin_bit_cast(bf16x8, pk[1][u]);
#pragma unroll
        for (int jd = 0; jd < 8; ++jd) {
          if ((jd & 3) == 0) asm volatile("" ::: "memory");
          const bf16_t* vp = Vs + (16 * jd + r16) * LDT + 32 * u + 4 * q4;
          const s16x4 lo = *(const s16x4*)vp, hi = *(const s16x4*)(vp + 16);
          const bf16x8 vf = __builtin_shufflevector(lo, hi, 0, 1, 2, 3, 4, 5, 6, 7);
          O[0][jd] = MFMA16(vf, pf0, O[0][jd]);
          O[1][jd] = MFMA16(vf, pf1, O[1][jd]);
        }
      }
    }
  }
  float L1 = Ls[0], L2 = Ls[1];
  L1 += __shfl_xor(L1, 16); L1 += __shfl_xor(L1, 32);
  L2 += __shfl_xor(L2, 16); L2 += __shfl_xor(L2, 32);
  const float i1 = 1.0f / L1, i2 = lam / L2;
  float ss = 0.f;
#pragma unroll
  for (int jd = 0; jd < 8; ++jd)
#pragma unroll
    for (int e = 0; e < 4; ++e) { const float o = O[0][jd][e] * i1 - O[1][jd][e] * i2; O[0][jd][e] = o; ss += o * o; }
  ss += __shfl_xor(ss, 16); ss += __shfl_xor(ss, 32);
  const float rs = rsqrtf(ss * (1.0f / 128.0f) + EPS) * oml;
  const bf16_t* ZA = NAT + (size_t)t * NATW + C_ZA + hd * 128;
  bf16_t* HA = (bf16_t*)(ws + OFF_HA) + ((size_t)bl * 4096 + t) * 1024 + hd * 128;
  const float* ag = p.anorm_g + l * 1024 + hd * 128;
#pragma unroll
  for (int jd = 0; jd < 8; ++jd) {
    const int dv = 16 * jd + 4 * q4;
    const u32x2 zv = *(const u32x2*)(ZA + dv);
    const f32x4 gg = *(const f32x4*)(ag + dv);
    u32x2 o;
    o[0] = pack2(O[0][jd][0] * rs * gg[0] * siluf_(bflo(zv[0])), O[0][jd][1] * rs * gg[1] * siluf_(bfhi(zv[0])));
    o[1] = pack2(O[0][jd][2] * rs * gg[2] * siluf_(bflo(zv[1])), O[0][jd][3] * rs * gg[3] * siluf_(bfhi(zv[1])));
    *(u32x2*)(HA + dv) = o;
  }
}

DI void proj_tile(const Params& p, int l, int mt, int nt, bf16_t* sm) {
  unsigned char* ws = p.ws;
  f32x16 acc[2][2];
  acc_zero(acc);
  f32x4 rsv[2];
  {
    const int lane_ = get_tid() & 63, w_ = get_tid() >> 6;
#pragma unroll
    for (int i = 0; i < 2; ++i) rsv[i] = *(const f32x4*)((const float*)(ws + OFF_RS) + ((size_t)mt * 128 + 64 * (w_ >> 1) + 32 * i + (lane_ & 31)) * 4);
  }
  gemm_core<false, true>((const bf16_t*)(ws + OFF_HM) + (size_t)mt * 128 * 2048, 2048, (const bf16_t*)(ws + OFF_WTPM) + ((size_t)l * 1024 + nt * 128) * 2048, 2048, 2048, acc, sm, nullptr, 0, [&](int kt) {
    if (kt == 8) {
#pragma unroll
      for (int i = 0; i < 2; ++i) { const float f = rsv[i][0] / rsv[i][1]; acc[i][0] *= f; acc[i][1] *= f; }
    } else if (kt == 16) {
#pragma unroll
      for (int i = 0; i < 2; ++i) { const float f = rsv[i][1] / rsv[i][2]; acc[i][0] *= f; acc[i][1] *= f; }
    } else if (kt == 24) {
#pragma unroll
      for (int i = 0; i < 2; ++i) { const float f = rsv[i][2] / rsv[i][3]; acc[i][0] *= f; acc[i][1] *= f; }
    }
  });
#pragma unroll
  for (int i = 0; i < 2; ++i) { acc[i][0] *= rsv[i][3]; acc[i][1] *= rsv[i][3]; }
  const bf16_t* G = (const bf16_t*)(ws + OFF_NAT) + (size_t)mt * 128 * NATW + nt * 128;
  for_quads(acc, [&](int ar, int br, int ii, float& v0, float& v1, float& v2, float& v3) {
    const u32x2 gm = *(const u32x2*)(G + (size_t)ar * NATW + C_GM + br), ga = *(const u32x2*)(G + (size_t)ar * NATW + C_GA + br);
    v0 *= (1.0f + __expf(-bflo(ga[0]))) / (1.0f + __expf(-bflo(gm[0])));
    v1 *= (1.0f + __expf(-bfhi(ga[0]))) / (1.0f + __expf(-bfhi(gm[0])));
    v2 *= (1.0f + __expf(-bflo(ga[1]))) / (1.0f + __expf(-bflo(gm[1])));
    v3 *= (1.0f + __expf(-bfhi(ga[1]))) / (1.0f + __expf(-bfhi(gm[1])));
  });
  gemm_core<false, true>((const bf16_t*)(ws + OFF_HA) + (size_t)mt * 128 * 1024, 1024, (const bf16_t*)(ws + OFF_WTPA) + ((size_t)l * 1024 + nt * 128) * 1024, 1024, 1024, acc, sm, nullptr, 0);
  bf16_t* Y = (bf16_t*)(ws + OFF_Q) + (size_t)mt * 128 * 1024 + nt * 128;
  for_quads(acc, [&](int ar, int br, int ii, float& v0, float& v1, float& v2, float& v3) {
    const u32x2 ga = *(const u32x2*)(G + (size_t)ar * NATW + C_GA + br);
    v0 *= sigmoidf_(bflo(ga[0])); v1 *= sigmoidf_(bfhi(ga[0])); v2 *= sigmoidf_(bflo(ga[1])); v3 *= sigmoidf_(bfhi(ga[1]));
  });
  store_acc_bf16x8(acc, Y, 1024);
}

DI void out_tile(const Params& p, int l, int grp, int mt, int nt, bf16_t* sm) {
  unsigned char* ws = p.ws;
  f32x16 acc[2][2];
  acc_zero(acc);
  gemm_core<false, true>((const bf16_t*)(ws + OFF_Q) + (size_t)mt * 128 * 1024, 1024, (const bf16_t*)(ws + OFF_WTOUT) + ((size_t)l * 1024 + nt * 128) * 1024, 1024, 1024, acc, sm, nullptr, 0);
  const float* xin = ((l == 0) ? p.x : p.out) + ((size_t)grp * TOK + mt * 128) * DM + nt * 128;
  float* xo = p.out + ((size_t)grp * TOK + mt * 128) * DM + nt * 128;
  const float* gate = (const float*)(ws + OFF_MOD) + (l * 8 + grp * 2 + (mt >> 5)) * 3072 + 2048 + nt * 128;
  for_quads(acc, [&](int ar, int br, int ii, float v0, float v1, float v2, float v3) {
    const f32x4 xv = *(const f32x4*)(xin + (size_t)ar * DM + br);
    const f32x4 gv = *(const f32x4*)(gate + br);
    f32x4 o; o[0] = xv[0] + gv[0] * v0; o[1] = xv[1] + gv[1] * v1; o[2] = xv[2] + gv[2] * v2; o[3] = xv[3] + gv[3] * v3;
    *(f32x4*)(xo + (size_t)ar * DM + br) = o;
  });
}

DI void final_norm(const Params& p) {
  const int tid = get_tid(), lane = tid & 63, w = tid >> 6;
  for (int it = blockIdx.x; it < NBATCH * SEQ / 4; it += gridDim.x) {
    float* xr = p.out + ((size_t)it * 4 + w) * DM;
    f32x4 xv[4];
    float ss = 0.f;
#pragma unroll
    for (int i = 0; i < 4; ++i) { xv[i] = *(const f32x4*)(xr + 256 * i + 4 * lane); ss += xv[i][0] * xv[i][0] + xv[i][1] * xv[i][1] + xv[i][2] * xv[i][2] + xv[i][3] * xv[i][3]; }
    ss = wave_sum(ss);
    const float rstd = rsqrtf(ss * (1.0f / DM) + EPS);
#pragma unroll
    for (int i = 0; i < 4; ++i) {
      const f32x4 g = *(const f32x4*)(p.final_g + 256 * i + 4 * lane);
      f32x4 o; o[0] = xv[i][0] * rstd * g[0]; o[1] = xv[i][1] * rstd * g[1]; o[2] = xv[i][2] * rstd * g[2]; o[3] = xv[i][3] * rstd * g[3];
      *(f32x4*)(xr + 256 * i + 4 * lane) = o;
    }
  }
}


#define XB_TMO      128
#define XB_XCNT(j)  (256  + 64 * (j))
#define XB_XSUB(j)  (1280 + 64 * (j))
#define XB_XGEN(j)  (2304 + 64 * (j))
#define XB_TOP      3328
#define XB_TOPGEN   3392
#define XCD_BAR_WORDS 3456
#define XB_SPIN_CAP (1u << 22)
#define LAS __attribute__((address_space(3)))
DI unsigned xb_ld(unsigned* p) { return __hip_atomic_load(p, __ATOMIC_RELAXED, __HIP_MEMORY_SCOPE_AGENT); }
DI unsigned xb_add(unsigned* p, unsigned v) { return __hip_atomic_fetch_add(p, v, __ATOMIC_RELAXED, __HIP_MEMORY_SCOPE_AGENT); }
DI unsigned xb_xcc_id() { return (unsigned)__builtin_amdgcn_s_getreg((3 << 11) | 20) & 0xFu; }
#define XB_SPIN(cond, bar) do { unsigned _sp = 0; while (cond) { __builtin_amdgcn_s_sleep(1); \
    if ((++_sp & 255u) == 0u) { if (xb_ld(&(bar)[XB_TMO])) break; if (_sp > XB_SPIN_CAP) { atomicAdd(&(bar)[XB_TMO], 1u); break; } } } } while (0)
struct XcdBarrier { unsigned* bar; unsigned x; volatile LAS unsigned* st; };
DI XcdBarrier xcd_barrier_post(unsigned* bar, volatile LAS unsigned* st) {
  XcdBarrier b; b.bar = bar; b.x = xb_xcc_id(); b.st = st;
  if (threadIdx.x == 0) (void)xb_add(&bar[XB_XCNT(b.x)], 1u);
  return b;
}
DI void xcd_barrier_complete(unsigned* bar, unsigned x, unsigned& nloc, unsigned& nx) {
  const unsigned G = gridDim.x * gridDim.y * gridDim.z;
  unsigned sum, cnt, mine, sp = 0u;
  for (;;) {
    sum = 0u; cnt = 0u; mine = 0u;
#pragma unroll
    for (unsigned j = 0; j < 16; ++j) { const unsigned c = xb_ld(&bar[XB_XCNT(j)]); sum += c; cnt += (c > 0u) ? 1u : 0u; mine = (j == x) ? c : mine; }
    if (sum == G) break;
    __builtin_amdgcn_s_sleep(1);
    if ((++sp & 255u) == 0u) { if (xb_ld(&bar[XB_TMO])) break; if (sp > XB_SPIN_CAP) { atomicAdd(&bar[XB_TMO], 1u); break; } }
  }
  nloc = mine > 0u ? mine : 1u; nx = cnt > 0u ? cnt : 1u;
}
DI void xcd_barrier(const XcdBarrier& b) {
  asm volatile("s_waitcnt vmcnt(0)" ::: "memory");
  __syncthreads();
  if (threadIdx.x == 0) {
    unsigned* bar = b.bar;
    __builtin_amdgcn_s_waitcnt(0);
    unsigned nloc = b.st[0], nx = b.st[1];
    if (nloc == 0u) { xcd_barrier_complete(bar, b.x, nloc, nx); b.st[0] = nloc; b.st[1] = nx; }
    const unsigned old = xb_add(&bar[XB_XSUB(b.x)], 1u);
    const unsigned gen = old / nloc;
    if (old + 1u == (gen + 1u) * nloc) {
      __builtin_amdgcn_fence(__ATOMIC_RELEASE, "agent");
      asm volatile("s_waitcnt vmcnt(0)" ::: "memory");
      const unsigned og = xb_add(&bar[XB_TOP], 1u);
      const unsigned tg = og / nx;
      if (og + 1u == (tg + 1u) * nx) xb_add(&bar[XB_TOPGEN], 1u);
      else XB_SPIN(xb_ld(&bar[XB_TOPGEN]) == tg, bar);
      __builtin_amdgcn_fence(__ATOMIC_ACQUIRE, "agent");
      xb_add(&bar[XB_XGEN(b.x)], 1u);
      asm volatile("s_waitcnt vmcnt(0)" ::: "memory");
    } else {
      XB_SPIN(xb_ld(&bar[XB_XGEN(b.x)]) == gen, bar);
      __builtin_amdgcn_fence(__ATOMIC_ACQUIRE, "agent");
      asm volatile("s_waitcnt vmcnt(0)" ::: "memory");
    }
  }
  __syncthreads();
}

constexpr int SMEM_BYTES = (CORE_SM + 128 * LDP) * 2 + 1024 * 4;

__global__ void __launch_bounds__(256, 2) fwd_megakernel(Params p) {
  cg::grid_group grid = cg::this_grid();
#define GSYNC() xcd_barrier(xb)
  extern __shared__ __attribute__((aligned(16))) unsigned char smem_raw[];
  bf16_t* sm = (bf16_t*)smem_raw;
  __shared__ __attribute__((aligned(16))) unsigned s_static[8];
#define s_item (*(volatile int*)&s_static[4])
  const int tid = get_tid();
  int* cnt = (int*)(p.ws + OFF_CNT);
#ifdef PROBE_SEL_A
  float tacc[8] = {0.f, 0.f, 0.f, 0.f, 0.f, 0.f, 0.f, 0.f};
  unsigned long long tlast = wall_clock64();
#define TS(k) { const unsigned long long now_ = wall_clock64(); tacc[k] += (float)(now_ - tlast); tlast = now_; }
#elif defined(PROBE_AMP)
  unsigned long long tlast = wall_clock64();
#define TS(k) { if (blockIdx.x == 0) { const unsigned long long now_ = wall_clock64(); if ((k) == PROBE_AMP) { const unsigned long long dt_ = now_ - tlast; while (wall_clock64() - now_ < 4ull * dt_) __builtin_amdgcn_s_sleep(16); } tlast = wall_clock64(); } }
#else
#define TS(k)
#endif

  if (threadIdx.x < 8) s_static[threadIdx.x] = 0u;
  __syncthreads();
  XcdBarrier xb = xcd_barrier_post((unsigned*)(p.ws + OFF_BAR), (volatile LAS unsigned*)s_static);
  phase0(p, (float*)smem_raw);
#ifdef DBL_P0
  phase0(p, (float*)smem_raw);
#endif
  grid.sync();
  norm_rows(p, 0, 0, blockIdx.x, gridDim.x);
  GSYNC();
  TS(0)

  for (int rd = 0; rd < 8; ++rd) {
    const int l = rd >> 2;
    if (blockIdx.x < 8) gate_scan(p, blockIdx.x, (float*)smem_raw);
    if (rd > 0) for (int it = blockIdx.x; it < 512; it += gridDim.x) out_tile(p, (rd - 1) >> 2, (rd - 1) & 3, it & 63, it >> 6, sm);
#ifdef DBL_B
    for (int rep = 0; rep < 2; ++rep)
#endif
    for (int it = blockIdx.x; it < 64 * 112; it += gridDim.x) inproj_tile(p, l, it & 63, it >> 6, sm);
    GSYNC();
    TS(1)
#ifdef DBL_CONV
    for (int rep = 0; rep < 2; ++rep)
#endif
    for (int it = blockIdx.x; it < 512; it += gridDim.x) conv_item(p, l, it, (float*)smem_raw);
    if (rd < 7) norm_rows(p, (rd + 1) >> 2, (rd + 1) & 3, blockIdx.x, gridDim.x);
    GSYNC();
    TS(2)
#ifdef DBL_C1
    for (int rep = 0; rep < 2; ++rep)
#else
    const int rep = 0;
#endif
    for (;;) {
      const int rdx = rd + 8 * rep;
      __syncthreads();
      if (tid == 0) s_item = atomicAdd(&cnt[rdx * 16], 1);
      __syncthreads();
      const int it = s_item;
      if (it >= 64 + 1024 + 256) break;
      if (it < 64) state_chain(p, it, rdx, sm);
      else if (it < 448 || it >= 704) {
        int k, qb;
        if (it < 448) { k = it - 64; qb = 63 - (k >> 4); }
        else { k = it - 704; qb = 39 - (k >> 4); }
        attn_item(p, l, (k >> 3) & 1, k & 7, qb, sm);
      } else mlstm_out_item(p, l, it - 448, rdx, sm);
    }
    GSYNC();
    TS(4)
#ifdef DBL_PROJ
    for (int rep = 0; rep < 2; ++rep)
#endif
    for (int it = blockIdx.x; it < 512; it += gridDim.x) proj_tile(p, l, it & 63, it >> 6, sm);
    GSYNC();
    TS(5)
  }
  for (int it = blockIdx.x; it < 512; it += gridDim.x) out_tile(p, 1, 3, it & 63, it >> 6, sm);
  GSYNC();
  TS(6)
  final_norm(p);
#ifdef PROBE_SEL_A
  TS(7)
  __syncthreads();
  if (blockIdx.x == 0 && tid == 0) { p.out[0] += tacc[PROBE_SEL_A] * 0.01f; p.out[1] += tacc[PROBE_SEL_B] * 0.01f; }
#endif
}

extern "C" void kernel_launch(void* const* d_in, const int* in_sizes, int n_in, void* d_out, int out_size, void* d_ws, size_t ws_size, hipStream_t stream) {
  static int grid_blocks = 0;
  if (!grid_blocks) {
    int dev = 0, cus = 0, per_cu = 0;
    hipGetDevice(&dev);
    hipDeviceGetAttribute(&cus, hipDeviceAttributeMultiprocessorCount, dev);
    hipFuncSetAttribute((const void*)fwd_megakernel, hipFuncAttributeMaxDynamicSharedMemorySize, SMEM_BYTES);
    hipOccupancyMaxActiveBlocksPerMultiprocessor(&per_cu, (const void*)fwd_megakernel, 256, SMEM_BYTES);
    if (per_cu < 1) per_cu = 1;
    if (per_cu > 2) per_cu = 2;
    grid_blocks = cus * per_cu;
    if (ws_size < WS_END) fprintf(stderr, "kernel_launch: workspace too small: %zu < %zu\n", ws_size, (size_t)WS_END);
  }
  Params p{};
  const float** pp = (const float**)&p;
  for (int i = 0; i < 20; ++i) pp[i] = (const float*)d_in[i];
  p.out = (float*)d_out;
  p.ws = (unsigned char*)d_ws;
  hipMemsetAsync(d_ws, 0, 20480, stream);
  void* args[] = {&p};
  hipError_t e = hipLaunchCooperativeKernel((const void*)fwd_megakernel, dim3(grid_blocks), dim3(256), args, SMEM_BYTES, stream);
  if (e != hipSuccess) fprintf(stderr, "cooperative launch failed: %s (grid %d)\n", hipGetErrorString(e), grid_blocks);
}
```
